# Optimizing an MI355X kernel written in HIP

```python
import math
import jax, jax.numpy as jnp
from jax import lax
import numpy as np

D_MODEL = 1024
BATCH = 16
SEQ = 2048
DEPTH = 1

RMS_EPS = 1e-6
D_FF = 2816
BLOCK = 128
MLA_HEADS = 8
MLA_Q_RANK = 256
MLA_KV_RANK = 128
MLA_NOPE = 64
MLA_ROPE = 32
MLA_V = 64
ROPE_THETA = 10000.0
SWA_HEADS = 8
SWA_KV_HEADS = 2
SWA_HEAD_DIM = 64
SWA_GROUP = SWA_HEADS // SWA_KV_HEADS
WINDOW = 128
N_SIDE = -(-WINDOW // BLOCK)
PAD = N_SIDE * BLOCK
KEY_SPAN = (2 * N_SIDE + 1) * BLOCK

MLA_OUT = MLA_HEADS * MLA_V
SWA_OUT = SWA_HEADS * SWA_HEAD_DIM
MIX_WIDTH = MLA_OUT + SWA_OUT
IN_SPLITS = [MLA_Q_RANK, MLA_KV_RANK, MLA_ROPE,
             SWA_HEADS * SWA_HEAD_DIM, SWA_KV_HEADS * SWA_HEAD_DIM, SWA_KV_HEADS * SWA_HEAD_DIM]
IN_WIDTH = sum(IN_SPLITS)

kernel_name = "hybrid_mla_swa_macaron_encoder_layer"


def rms_norm(x, g, eps=RMS_EPS):
    xf = x.astype(jnp.float32)
    y = xf * lax.rsqrt(jnp.mean(xf * xf, axis=-1, keepdims=True) + eps)
    return (y * g.astype(jnp.float32)).astype(x.dtype)


def swiglu(x, w_gate, w_up, w_down):
    return (jax.nn.silu(x @ w_gate) * (x @ w_up)) @ w_down


def rope_tables(seq_len, dim):
    pos = jnp.arange(seq_len, dtype=jnp.float32)
    inv = 1.0 / (ROPE_THETA ** (jnp.arange(0, dim, 2, dtype=jnp.float32) / dim))
    ang = pos[:, None] * inv[None, :]
    return jnp.cos(ang), jnp.sin(ang)


def apply_rope(x, cos, sin):
    xf = x.astype(jnp.float32)
    x1, x2 = jnp.split(xf, 2, axis=-1)
    return jnp.concatenate([x1 * cos - x2 * sin, x2 * cos + x1 * sin], axis=-1).astype(x.dtype)


def mla_mixer(hq, hkv, hkr, g_q_a, w_uq, g_kv_a, w_ukv, g_qn, g_qr, g_kn, g_kr):
    B, S, _ = hq.shape
    nb = S // BLOCK
    cos, sin = rope_tables(S, MLA_ROPE)
    c_q = rms_norm(hq, g_q_a)
    q = (c_q @ w_uq).reshape(B, S, MLA_HEADS, MLA_NOPE + MLA_ROPE)
    q_nope = rms_norm(q[..., :MLA_NOPE], g_qn)
    q_pe = apply_rope(rms_norm(q[..., MLA_NOPE:], g_qr), cos[:, None], sin[:, None])
    c_kv = rms_norm(hkv, g_kv_a)
    kv = (c_kv @ w_ukv).reshape(B, S, MLA_HEADS, MLA_NOPE + MLA_V)
    k_nope = rms_norm(kv[..., :MLA_NOPE], g_kn)
    v = kv[..., MLA_NOPE:]
    k_pe = apply_rope(rms_norm(hkr, g_kr), cos, sin)
    scale = 1.0 / math.sqrt(MLA_NOPE + MLA_ROPE)
    qn_b = jnp.moveaxis(q_nope.reshape(B, nb, BLOCK, MLA_HEADS, MLA_NOPE), 1, 0)
    qp_b = jnp.moveaxis(q_pe.reshape(B, nb, BLOCK, MLA_HEADS, MLA_ROPE), 1, 0)

    def one_block(args):
        qn, qp = args
        s = (jnp.einsum('bqhd,bkhd->bhqk', qn, k_nope).astype(jnp.float32)
             + jnp.einsum('bqhr,bkr->bhqk', qp, k_pe).astype(jnp.float32)) * scale
        p = jax.nn.softmax(s, axis=-1)
        return jnp.einsum('bhqk,bkhd->bqhd', p.astype(v.dtype), v)

    out = lax.map(one_block, (qn_b, qp_b))
    return jnp.moveaxis(out, 0, 1).reshape(B, S, MLA_OUT)


def swa_mixer(q, k, v, g_q, g_k, sink):
    B, S, _ = q.shape
    nb = S // BLOCK
    D = SWA_HEAD_DIM
    q = rms_norm(q.reshape(B, S, SWA_HEADS, D), g_q)
    k = rms_norm(k.reshape(B, S, SWA_KV_HEADS, D), g_k)
    v = v.reshape(B, S, SWA_KV_HEADS, D)
    qb = q.reshape(B, nb, BLOCK, SWA_KV_HEADS, SWA_GROUP, D)
    kp = jnp.pad(k, ((0, 0), (PAD, PAD), (0, 0), (0, 0)))
    vp = jnp.pad(v, ((0, 0), (PAD, PAD), (0, 0), (0, 0)))
    kb = jnp.concatenate([kp[:, j * BLOCK:j * BLOCK + S].reshape(B, nb, BLOCK, SWA_KV_HEADS, D)
                          for j in range(2 * N_SIDE + 1)], axis=2)
    vb = jnp.concatenate([vp[:, j * BLOCK:j * BLOCK + S].reshape(B, nb, BLOCK, SWA_KV_HEADS, D)
                          for j in range(2 * N_SIDE + 1)], axis=2)
    qi = jnp.arange(BLOCK)[:, None]
    kj = jnp.arange(KEY_SPAN)[None, :]
    rel = kj - PAD - qi
    s_abs = jnp.arange(nb)[:, None, None] * BLOCK - PAD + kj[None]
    valid = (jnp.abs(rel)[None] <= WINDOW) & (s_abs >= 0) & (s_abs < S)
    slopes = 2.0 ** (-(8.0 / SWA_HEADS) * jnp.arange(1, SWA_HEADS + 1, dtype=jnp.float32))
    alibi = -slopes.reshape(SWA_KV_HEADS, SWA_GROUP)[:, :, None, None, None] * \
        jnp.abs(rel).astype(jnp.float32)[None, None, None]
    logits = jnp.einsum('bnqhgd,bnkhd->bhgnqk', qb, kb).astype(jnp.float32) / math.sqrt(D)
    logits = jnp.where(valid, logits + alibi[None], -jnp.inf)
    sk = sink.astype(jnp.float32).reshape(SWA_KV_HEADS, SWA_GROUP)[None, :, :, None, None, None]
    m = jnp.maximum(jnp.max(logits, axis=-1, keepdims=True), sk)
    p = jnp.exp(logits - m)
    w = p / (jnp.sum(p, axis=-1, keepdims=True) + jnp.exp(sk - m))
    out = jnp.einsum('bhgnqk,bnkhd->bnqhgd', w.astype(vb.dtype), vb)
    return out.reshape(B, S, SWA_OUT)


def setup_inputs(seed: int = 0) -> dict:
    key = jax.random.key(seed)
    ks = jax.random.split(key, 24)

    def w(k, shape):
        return jax.random.normal(k, shape, jnp.float32) * shape[0] ** -0.5

    def g(k, n):
        return 1.0 + 0.02 * jax.random.normal(k, (n,), jnp.float32)

    return {
        "x": jax.random.normal(ks[0], (BATCH, SEQ, D_MODEL), jnp.float32),
        "g_ffn1": g(ks[1], D_MODEL),
        "w1_gate": w(ks[2], (D_MODEL, D_FF)),
        "w1_up": w(ks[3], (D_MODEL, D_FF)),
        "w1_down": w(ks[4], (D_FF, D_MODEL)),
        "g_mix": g(ks[5], D_MODEL),
        "w_in": w(ks[6], (D_MODEL, IN_WIDTH)),
        "g_q_a": g(ks[7], MLA_Q_RANK),
        "w_uq": w(ks[8], (MLA_Q_RANK, MLA_HEADS * (MLA_NOPE + MLA_ROPE))),
        "g_kv_a": g(ks[9], MLA_KV_RANK),
        "w_ukv": w(ks[10], (MLA_KV_RANK, MLA_HEADS * (MLA_NOPE + MLA_V))),
        "g_mla_qn": g(ks[11], MLA_NOPE),
        "g_mla_qr": g(ks[12], MLA_ROPE),
        "g_mla_kn": g(ks[13], MLA_NOPE),
        "g_mla_kr": g(ks[14], MLA_ROPE),
        "g_swa_q": g(ks[15], SWA_HEAD_DIM),
        "g_swa_k": g(ks[16], SWA_HEAD_DIM),
        "sink": 0.5 * jax.random.normal(ks[17], (SWA_HEADS,), jnp.float32),
        "w_o": w(ks[18], (MIX_WIDTH, D_MODEL)),
        "g_ffn2": g(ks[19], D_MODEL),
        "w2_gate": w(ks[20], (D_MODEL, D_FF)),
        "w2_up": w(ks[21], (D_MODEL, D_FF)),
        "w2_down": w(ks[22], (D_FF, D_MODEL)),
    }


def reference(x, g_ffn1, w1_gate, w1_up, w1_down, g_mix, w_in, g_q_a, w_uq, g_kv_a, w_ukv,
              g_mla_qn, g_mla_qr, g_mla_kn, g_mla_kr, g_swa_q, g_swa_k, sink, w_o,
              g_ffn2, w2_gate, w2_up, w2_down):
    split_idx = list(np.cumsum(IN_SPLITS)[:-1])
    for _ in range(DEPTH):
        x = x + 0.5 * swiglu(rms_norm(x, g_ffn1), w1_gate, w1_up, w1_down)
        h = rms_norm(x, g_mix)
        hq, hkv, hkr, sq, sk_, sv = jnp.split(h @ w_in, split_idx, axis=-1)
        y_a = mla_mixer(hq, hkv, hkr, g_q_a, w_uq, g_kv_a, w_ukv,
                        g_mla_qn, g_mla_qr, g_mla_kn, g_mla_kr)
        y_b = swa_mixer(sq, sk_, sv, g_swa_q, g_swa_k, sink)
        x = x + jnp.concatenate([y_a, y_b], axis=-1) @ w_o
        x = x + 0.5 * swiglu(rms_norm(x, g_ffn2), w2_gate, w2_up, w2_down)
    return x
```

```cpp
#include <hip/hip_runtime.h>
#include <hip/hip_bf16.h>
#include <cstdio>
#include <cstdint>
#include <cmath>

#ifndef MK_N_LAUNCHES
#define MK_N_LAUNCHES 1
#endif
#ifndef MK_ALIGN_GU
#define MK_ALIGN_GU true
#endif
#ifndef MK_TST
#define MK_TST 1
#endif
#ifndef MK_TST_GU
#define MK_TST_GU 1
#endif
#ifndef MK_DUP
#define MK_DUP -1
#endif
#define REPS(k) for (int rep = 0; rep < ((MK_DUP == (k)) ? 2 : 1); ++rep)

namespace pg8 {
#define PG8_LAS __attribute__((address_space(3)))
typedef unsigned short bf16_t;
typedef short bf16x8 __attribute__((ext_vector_type(8)));
typedef float f32x4 __attribute__((ext_vector_type(4)));
typedef unsigned u32x4 __attribute__((ext_vector_type(4)));
constexpr int BM = 256, BK = 64, HALF = 128, HTB = HALF * BK * 2  , STAGE_BYTES = 8 * HTB, NXCD = 8, WGM = 8;
constexpr float RMS_EPS = 1e-6f;
constexpr float LOG2E = 1.4426950408889634f;

__host__ __device__ __forceinline__ int lds_byte(int r, int c) { const int st = (r >> 4) * 2 + (c >> 5), rr = r & 15, cc = c & 31, ob = rr * 64 + cc * 2; return st * 1024 + (ob ^ (((ob >> 9) & 1) << 5)); }
__host__ __device__ __forceinline__ void stage_rc(int b, int& R, int& C) { const int st = b / 1024, sb = b % 1024, swz = sb ^ (((sb >> 9) & 1) << 5); R = (st >> 1) * 16 + swz / 64; C = (st & 1) * 32 + (swz % 64) / 2; }
__host__ __device__ __forceinline__ int perm32(int rho) { const int n = rho >> 4, i = rho & 15; return 8 * (i >> 2) + 4 * n + (i & 3); }

struct Unit { int pm, pn, koff, nt, par; };
struct Gemm { const bf16_t* A; const bf16_t* Bt; int M, N, K; };

struct StaticOrder {
    int nM, nN, nwg, G, c, nt;
    __host__ __device__ void init(int M, int N, int K, int G_, int c_) { nM = M / BM; nN = N / BM; nwg = nM * nN; G = G_; c = c_; nt = K / BK; }
    __host__ __device__ bool next(int i, Unit& u) const {
        const long L = (long)i * G + c; if (L >= nwg) return false;
        int wgid = (int)L; { const int q = nwg / NXCD, r = nwg % NXCD, xcd = wgid % NXCD, off = wgid / NXCD; wgid = (xcd < r ? xcd * (q + 1) : r * (q + 1) + (xcd - r) * q) + off; }
        const int nig = WGM * nN, gid = wgid / nig, fm = gid * WGM, gsz = (nM - fm) < WGM ? (nM - fm) : WGM;
        u.pm = fm + ((wgid % nig) % gsz); u.pn = (wgid % nig) / gsz; u.koff = 0; u.nt = nt; u.par = i & 1; return true;
    }
    __device__ __forceinline__ void a_ready(const Unit&) const {}
    __device__ __forceinline__ void done(const Unit&) const {}
};

struct UpOrder {
    StaticOrder S;
    __device__ bool next(int i, Unit& u) const { if (!S.next(i, u)) return false; if (u.pn < 3) { u.koff = 0; u.nt = 4; } else { u.koff = 256 * 2; u.nt = 2; } return true; }
    __device__ __forceinline__ void a_ready(const Unit&) const {}
    __device__ __forceinline__ void done(const Unit&) const {}
};

constexpr int SSB_OFF = STAGE_BYTES + 2048;
template <class Base> struct StatOrder {
    Base S; const float* ssA; const float* ssB; int pnB;
    PG8_LAS unsigned char* lds;
    __device__ bool next(int i, Unit& u) const { return S.next(i, u); }
    __device__ __forceinline__ void a_ready(const Unit& u) const {
        const int tid = threadIdx.x, w = __builtin_amdgcn_readfirstlane(tid >> 6);
        if (w < 4) { const float* src = (u.pn < pnB ? ssA : ssB) + u.pm * BM + tid;
            __builtin_amdgcn_global_load_lds((const unsigned*)src, (PG8_LAS unsigned*)(lds + SSB_OFF + u.par * 1024 + w * 256), 4, 0, 0); }
    }
    __device__ __forceinline__ void done(const Unit&) const {}
};
__device__ __forceinline__ void lds_rows8(float (&v)[2][4], PG8_LAS unsigned char* lds, const Unit& u, int wr, int fr) {
    const PG8_LAS float* p = (const PG8_LAS float*)(lds + SSB_OFF + u.par * 1024) + wr * 64 + fr;
#pragma unroll
    for (int ai = 0; ai < 2; ++ai)
#pragma unroll
        for (int m = 0; m < 4; ++m) v[ai][m] = p[ai * HALF + m * 16];
}

__device__ __forceinline__ unsigned cvt_pk_bf16(float lo, float hi) { unsigned r; asm volatile("v_cvt_pk_bf16_f32 %0, %1, %2" : "=v"(r) : "v"(lo), "v"(hi)); return r; }
__device__ __forceinline__ u32x4 pack8(const f32x4 a, const f32x4 b) { u32x4 w; w.x = cvt_pk_bf16(a[0], a[1]); w.y = cvt_pk_bf16(a[2], a[3]); w.z = cvt_pk_bf16(b[0], b[1]); w.w = cvt_pk_bf16(b[2], b[3]); return w; }
struct TSt { PG8_LAS unsigned char* a0; PG8_LAS unsigned char* a1; int wofs, rofs, wofs32, rofs32, drow, c3, fr, fq, lane; };
__device__ __forceinline__ TSt tst_init(PG8_LAS unsigned char* lds, int wr, int wc, int fr, int fq) {
    const int wid = wr * 4 + wc, lane = fr + 16 * fq; TSt t;
    t.a0 = lds + 3 * HTB + wid * 1024; t.a1 = t.a0 + 8192;
    t.wofs = fr * 64 + ((fq ^ ((fr >> 1) & 3)) * 16); t.rofs = (lane >> 2) * 64 + (((lane & 3) ^ ((lane >> 3) & 3)) * 16);
    t.wofs32 = (fr & 7) * 128 + (((2 * fq) ^ (fr & 7)) * 16); t.rofs32 = (lane >> 3) * 128 + (((lane & 7) ^ (lane >> 3)) * 16);
    t.drow = (lane >> 2) - fr; t.c3 = 8 * (lane & 3); t.fr = fr; t.fq = fq; t.lane = lane; return t; }
__device__ __forceinline__ void tst16(const TSt& t, int sel, const u32x4 w, bf16_t* P, int pitch) {
#if MK_TST
    PG8_LAS unsigned char* a = sel ? t.a1 : t.a0;
    *(PG8_LAS u32x4*)(a + t.wofs) = w;
    const u32x4 v = *(const PG8_LAS u32x4*)(a + t.rofs);
    *(u32x4*)(P + (long)t.drow * pitch + t.c3) = v;
#else
    *(u32x4*)(P + 8 * t.fq) = w;
#endif
}
__device__ __forceinline__ void tst32f(const TSt& t, const f32x4 v0, const f32x4 v1, float* P, int pitch) {
#if MK_TST
    PG8_LAS unsigned char* aw = ((t.fr & 8) ? t.a1 : t.a0) + t.wofs32;
    *(PG8_LAS f32x4*)(aw) = v0; *(PG8_LAS f32x4*)(((t.fr & 8) ? t.a1 : t.a0) + (t.wofs32 ^ 16)) = v1;
    const f32x4 r0 = *(const PG8_LAS f32x4*)(t.a0 + t.rofs32), r1 = *(const PG8_LAS f32x4*)(t.a1 + t.rofs32);
    float* Q = P + (long)((t.lane >> 3) - t.fr) * pitch + 4 * (t.lane & 7);
    *(f32x4*)Q = r0; *(f32x4*)(Q + (long)8 * pitch) = r1;
#else
    *(f32x4*)(P + 8 * t.fq) = v0; *(f32x4*)(P + 8 * t.fq + 4) = v1;
#endif
}
__device__ __forceinline__ float dot4(const f32x4 a) { return (a[0] * a[0] + a[1] * a[1]) + (a[2] * a[2] + a[3] * a[3]); }
__device__ __forceinline__ float hsum4(f32x4 t) { asm("" : "+v"(t)); return (t[0] + t[1]) + (t[2] + t[3]); }
__device__ __forceinline__ float sumsq8(const f32x4 a, const f32x4 b) { f32x4 t = a * a; t = b * b + t; return hsum4(t); }
__device__ __forceinline__ float sumsq16(const f32x4 a, const f32x4 b, const f32x4 c, const f32x4 d) { f32x4 t = a * a; t = b * b + t; t = c * c + t; t = d * d + t; return hsum4(t); }
__device__ __forceinline__ float sum_fq(float s) {
    const auto a = __builtin_amdgcn_permlane32_swap(__float_as_uint(s), __float_as_uint(s), false, false); s = __uint_as_float(a[0]) + __uint_as_float(a[1]);
    const auto b = __builtin_amdgcn_permlane16_swap(__float_as_uint(s), __float_as_uint(s), false, false); return __uint_as_float(b[0]) + __uint_as_float(b[1]); }
__device__ __forceinline__ float silu_f(float g) { return g * __builtin_amdgcn_rcpf(1.0f + __builtin_amdgcn_exp2f(-LOG2E * g)); }
__device__ __forceinline__ float rs_of(float ss, float inv_n) { return __builtin_amdgcn_rsqf(ss * inv_n + RMS_EPS); }

__device__ __forceinline__ void load_rows8(float (&v)[2][4], const float* p, int row0) {
#pragma unroll
    for (int ai = 0; ai < 2; ++ai)
#pragma unroll
        for (int m = 0; m < 4; ++m) v[ai][m] = p[row0 + ai * HALF + m * 16];
    asm volatile("" : "+v"(v[0][0]), "+v"(v[0][1]), "+v"(v[0][2]), "+v"(v[0][3]), "+v"(v[1][0]), "+v"(v[1][1]), "+v"(v[1][2]), "+v"(v[1][3]));
}

struct EpiSwiGLU {
    static constexpr bool PERM = true, AFTER_DRAIN = false;
    bf16_t* H; PG8_LAS unsigned char* lds; int ldh;
    __device__ __forceinline__ void operator()(const f32x4 (&acc)[2][2][4][2], const Unit& u, int wr, int wc, int fr, int fq) const {
        asm volatile("" : "+v"(fr), "+v"(fq));
        const int row0 = u.pm * BM + wr * 64 + fr, colb = u.pn * HALF + wc * 32;
        const TSt T = tst_init(lds, wr, wc, fr, fq);
        float sv[2][4]; lds_rows8(sv, lds, u, wr, fr);
#pragma unroll
        for (int ai = 0; ai < 2; ++ai)
#pragma unroll
            for (int m = 0; m < 4; ++m) {
                const int row = row0 + ai * HALF + m * 16;
                const float ir2 = sv[ai][m] * (1.0f / 1024.0f) + RMS_EPS, c = -LOG2E * __builtin_amdgcn_rsqf(ir2);
                f32x4 h[2];
#pragma unroll
                for (int n = 0; n < 2; ++n) { const f32x4 g = acc[ai][0][m][n], up = acc[ai][1][m][n]; const f32x4 t = g * c; f32x4 e, w;
#pragma unroll
                    for (int i = 0; i < 4; ++i) e[i] = __builtin_amdgcn_exp2f(t[i]);
                    const f32x4 d = e * ir2 + ir2;
#pragma unroll
                    for (int i = 0; i < 4; ++i) w[i] = __builtin_amdgcn_rcpf(d[i]);
                    h[n] = (g * up) * w; }
                if (MK_TST_GU) tst16(T, m & 1, pack8(h[0], h[1]), H + (size_t)row * ldh + colb, ldh);
                else *(u32x4*)(H + (size_t)row * ldh + colb + 8 * fq) = pack8(h[0], h[1]);
            }
    }
};

__device__ __forceinline__ void unpack8(const u32x4 w, f32x4& a, f32x4& b) {
    a[0] = __uint_as_float(w.x << 16); a[1] = __uint_as_float(w.x & 0xffff0000u); a[2] = __uint_as_float(w.y << 16); a[3] = __uint_as_float(w.y & 0xffff0000u);
    b[0] = __uint_as_float(w.z << 16); b[1] = __uint_as_float(w.z & 0xffff0000u); b[2] = __uint_as_float(w.w << 16); b[3] = __uint_as_float(w.w & 0xffff0000u); }
struct EpiRes {
    static constexpr bool PERM = true, AFTER_DRAIN = false;
    const bf16_t* base; bf16_t* xb; float* outf; float* ss; float alpha; PG8_LAS unsigned char* lds;
    __device__ __forceinline__ void operator()(const f32x4 (&acc)[2][2][4][2], const Unit& u, int wr, int wc, int fr, int fq) const {
        asm volatile("" : "+v"(fr), "+v"(fq));
        const int row0 = u.pm * BM + wr * 64 + fr, col0 = u.pn * BM + wc * 32 + 8 * fq, colb = u.pn * BM + wc * 32;
        const TSt T = tst_init(lds, wr, wc, fr, fq);
        u32x4 b[2][4][2];
#pragma unroll
        for (int ai = 0; ai < 2; ++ai)
#pragma unroll
            for (int m = 0; m < 4; ++m) { const size_t off = (size_t)(row0 + ai * HALF + m * 16) * 1024 + col0;
#pragma unroll
                for (int bj = 0; bj < 2; ++bj) b[ai][m][bj] = *(const u32x4*)(base + off + bj * HALF); }
#pragma unroll
        for (int ai = 0; ai < 2; ++ai)
#pragma unroll
            for (int m = 0; m < 4; ++m) asm volatile("" : "+v"(b[ai][m][0]), "+v"(b[ai][m][1]));
#pragma unroll
        for (int ai = 0; ai < 2; ++ai) {
#pragma unroll
            for (int m = 0; m < 4; ++m) { const int row = row0 + ai * HALF + m * 16; const size_t off = (size_t)row * 1024 + col0; float s = 0.f;
#pragma unroll
                for (int bj = 0; bj < 2; ++bj) { f32x4 b0, b1; unpack8(b[ai][m][bj], b0, b1);
                    const f32x4 v0 = b0 + acc[ai][bj][m][0] * alpha, v1 = b1 + acc[ai][bj][m][1] * alpha;
                    if (outf) tst32f(T, v0, v1, outf + (size_t)row * 1024 + colb + bj * HALF, 1024);
                    if (xb) tst16(T, bj, pack8(v0, v1), xb + (size_t)row * 1024 + colb + bj * HALF, 1024);
                    s += sumsq8(v0, v1); }
                if (ss) { s = sum_fq(s); if (fq == 0) unsafeAtomicAdd(ss + row, s); } }
        }
    }
};

struct EpiNull {
    static constexpr bool PERM = true, AFTER_DRAIN = false;
    __device__ __forceinline__ void operator()(const f32x4 (&acc)[2][2][4][2], const Unit&, int, int, int, int) const {
#pragma unroll
        for (int ai = 0; ai < 2; ++ai)
#pragma unroll
            for (int bj = 0; bj < 2; ++bj)
#pragma unroll
                for (int m = 0; m < 4; ++m) asm volatile("" :: "v"(acc[ai][bj][m][0]), "v"(acc[ai][bj][m][1]));
    }
};

struct MixBufs {
    bf16_t *HQKV, *KPE, *SQ, *SK, *SV, *QM, *KN, *VM;
    float *ssq, *sskv; const float *ss1;
    const float *g_kr, *g_sq, *g_sk, *g_qn, *g_qr, *g_kn;
    const float *rcos, *rsin;
    int noatom;
};
constexpr float C_SWA = 0.125f * LOG2E;
constexpr float C_MLA = 0.10206207261596577f * LOG2E;

__device__ __forceinline__ void head64_norm_store(const f32x4 v00, const f32x4 v01, const f32x4 v10, const f32x4 v11, float r, const f32x4 (&g)[2][2], float post, bf16_t* dst, int pitch, const TSt& T) {
    const float s = sum_fq(sumsq16(v00, v01, v10, v11));
    const float rr = rs_of(s * (r * r), 1.0f / 64.0f) * (r * post);
    tst16(T, 0, pack8(v00 * rr * g[0][0], v01 * rr * g[0][1]), dst, pitch);
    tst16(T, 1, pack8(v10 * rr * g[1][0], v11 * rr * g[1][1]), dst + 32, pitch);
}
__device__ __forceinline__ void rope32_norm_store_cs(f32x4 x1, f32x4 x2, float r, const f32x4 g1, const f32x4 g2, const f32x4 cs, const f32x4 sn, float post, bf16_t* dst, int pitch, const TSt& T) {
    const float s = sum_fq(sumsq8(x1, x2));
    const float rr = rs_of(s * (r * r), 1.0f / 32.0f) * (r * post);
    x1 = x1 * rr * g1; x2 = x2 * rr * g2;
    const f32x4 o1 = x1 * cs - x2 * sn, o2 = x2 * cs + x1 * sn;
    tst16(T, 0, pack8(o1, o2), dst, pitch);
}
__device__ __forceinline__ void load_rope4(f32x4 (&cs)[4], f32x4 (&sn)[4], const float* rcos, const float* rsin, int rowa, int fq) {
#pragma unroll
    for (int m = 0; m < 4; ++m) { const int pos = (rowa + m * 16) & 2047; cs[m] = *(const f32x4*)(rcos + pos * 16 + 4 * fq); sn[m] = *(const f32x4*)(rsin + pos * 16 + 4 * fq); }
#pragma unroll
    for (int m = 0; m < 4; ++m) asm volatile("" : "+v"(cs[m]), "+v"(sn[m]));
}
__device__ __forceinline__ void load_g64(f32x4 (&g)[2][2], const float* gp, int fq) {
#pragma unroll
    for (int bj = 0; bj < 2; ++bj)
#pragma unroll
        for (int n = 0; n < 2; ++n) g[bj][n] = *(const f32x4*)(gp + 32 * bj + 8 * fq + 4 * n);
}

struct EpiWin {
    static constexpr bool PERM = true, AFTER_DRAIN = false;
    MixBufs B; PG8_LAS unsigned char* lds;
    __device__ __forceinline__ void operator()(const f32x4 (&acc)[2][2][4][2], const Unit& u, int wr, int wc, int fr, int fq) const {
        asm volatile("" : "+v"(fr), "+v"(fq));
        const int row0 = u.pm * BM + wr * 64 + fr; const int pn = u.pn;
        const TSt T = tst_init(lds, wr, wc, fr, fq);
        float sv[2][4]; lds_rows8(sv, lds, u, wr, fr);
        if (pn == 0) {
#pragma unroll
            for (int ai = 0; ai < 2; ++ai)
#pragma unroll
                for (int m = 0; m < 4; ++m) { const int row = row0 + ai * HALF + m * 16; const float r = rs_of(sv[ai][m], 1.0f / 1024.0f); float s = 0.f;
#pragma unroll
                    for (int bj = 0; bj < 2; ++bj) { const f32x4 v0 = acc[ai][bj][m][0] * r, v1 = acc[ai][bj][m][1] * r; s += sumsq8(v0, v1);
                        tst16(T, bj, pack8(v0, v1), B.HQKV + (size_t)row * 384 + bj * HALF + wc * 32, 384); }
                    s = sum_fq(s); if (fq == 0 && !B.noatom) unsafeAtomicAdd(B.ssq + row, s); }
        } else if (pn == 1) {
            const f32x4 g1 = *(const f32x4*)(B.g_kr + 4 * fq), g2 = *(const f32x4*)(B.g_kr + 16 + 4 * fq);
#pragma unroll
            for (int ai = 0; ai < 2; ++ai) {
                f32x4 cs[4], sn[4]; if (wc == 0) load_rope4(cs, sn, B.rcos, B.rsin, row0 + ai * HALF, fq);
#pragma unroll
                for (int m = 0; m < 4; ++m) { const int row = row0 + ai * HALF + m * 16; const float r = rs_of(sv[ai][m], 1.0f / 1024.0f);
                    const f32x4 v0 = acc[ai][0][m][0] * r, v1 = acc[ai][0][m][1] * r;
                    tst16(T, 0, pack8(v0, v1), B.HQKV + (size_t)row * 384 + 256 + wc * 32, 384);
                    const float s = sum_fq(sumsq8(v0, v1)); if (fq == 0 && !B.noatom) unsafeAtomicAdd(B.sskv + row, s);
                    if (wc == 0) rope32_norm_store_cs(acc[ai][1][m][0], acc[ai][1][m][1], r, g1, g2, cs[m], sn[m], 1.0f, B.KPE + (size_t)row * 32, 32, T); } }
        } else if (pn < 4) {
            f32x4 g[2][2]; load_g64(g, B.g_sq, fq); const int head = 4 * (pn - 2) + wc;
#pragma unroll
            for (int ai = 0; ai < 2; ++ai)
#pragma unroll
                for (int m = 0; m < 4; ++m) { const int row = row0 + ai * HALF + m * 16; const float r = rs_of(sv[ai][m], 1.0f / 1024.0f);
                    head64_norm_store(acc[ai][0][m][0], acc[ai][0][m][1], acc[ai][1][m][0], acc[ai][1][m][1], r, g, C_SWA, B.SQ + (size_t)row * 512 + head * 64, 512, T); }
        } else {
            if (wc < 2) { f32x4 g[2][2]; load_g64(g, B.g_sk, fq);
#pragma unroll
                for (int ai = 0; ai < 2; ++ai)
#pragma unroll
                    for (int m = 0; m < 4; ++m) { const int row = row0 + ai * HALF + m * 16; const float r = rs_of(sv[ai][m], 1.0f / 1024.0f);
                        head64_norm_store(acc[ai][0][m][0], acc[ai][0][m][1], acc[ai][1][m][0], acc[ai][1][m][1], r, g, 1.0f, B.SK + (size_t)row * 128 + wc * 64, 128, T); }
            } else {
#pragma unroll
                for (int ai = 0; ai < 2; ++ai)
#pragma unroll
                    for (int m = 0; m < 4; ++m) { const int row = row0 + ai * HALF + m * 16; const float r = rs_of(sv[ai][m], 1.0f / 1024.0f); bf16_t* dst = B.SV + (size_t)row * 128 + (wc - 2) * 64;
                        tst16(T, 0, pack8(acc[ai][0][m][0] * r, acc[ai][0][m][1] * r), dst, 128); tst16(T, 1, pack8(acc[ai][1][m][0] * r, acc[ai][1][m][1] * r), dst + 32, 128); }
            }
        }
    }
};

struct EpiUp {
    static constexpr bool PERM = true, AFTER_DRAIN = false;
    MixBufs B; PG8_LAS unsigned char* lds;
    __device__ __forceinline__ void operator()(const f32x4 (&acc)[2][2][4][2], const Unit& u, int wr, int wc, int fr, int fq) const {
        asm volatile("" : "+v"(fr), "+v"(fq));
        const int row0 = u.pm * BM + wr * 64 + fr; const int pn = u.pn;
        const TSt T = tst_init(lds, wr, wc, fr, fq);
        float sv[2][4]; lds_rows8(sv, lds, u, wr, fr);
        if (pn < 2) {
            f32x4 g[2][2]; load_g64(g, B.g_qn, fq); const int head = 4 * pn + wc;
#pragma unroll
            for (int ai = 0; ai < 2; ++ai)
#pragma unroll
                for (int m = 0; m < 4; ++m) { const int row = row0 + ai * HALF + m * 16; const float r = rs_of(sv[ai][m], 1.0f / 256.0f);
                    head64_norm_store(acc[ai][0][m][0], acc[ai][0][m][1], acc[ai][1][m][0], acc[ai][1][m][1], r, g, C_MLA, B.QM + (size_t)row * 768 + head * 96, 768, T); }
        } else if (pn == 2) {
            const f32x4 g1 = *(const f32x4*)(B.g_qr + 4 * fq), g2 = *(const f32x4*)(B.g_qr + 16 + 4 * fq);
#pragma unroll
            for (int ai = 0; ai < 2; ++ai) {
                f32x4 cs[4], sn[4]; load_rope4(cs, sn, B.rcos, B.rsin, row0 + ai * HALF, fq);
#pragma unroll
                for (int m = 0; m < 4; ++m) { const int row = row0 + ai * HALF + m * 16; const float r = rs_of(sv[ai][m], 1.0f / 256.0f);
#pragma unroll
                    for (int bj = 0; bj < 2; ++bj) rope32_norm_store_cs(acc[ai][bj][m][0], acc[ai][bj][m][1], r, g1, g2, cs[m], sn[m], C_MLA, B.QM + (size_t)row * 768 + (4 * bj + wc) * 96 + 64, 768, T); } }
        } else if (pn < 5) {
            f32x4 g[2][2]; load_g64(g, B.g_kn, fq); const int head = 4 * (pn - 3) + wc;
#pragma unroll
            for (int ai = 0; ai < 2; ++ai)
#pragma unroll
                for (int m = 0; m < 4; ++m) { const int row = row0 + ai * HALF + m * 16; const float r = rs_of(sv[ai][m], 1.0f / 128.0f);
                    head64_norm_store(acc[ai][0][m][0], acc[ai][0][m][1], acc[ai][1][m][0], acc[ai][1][m][1], r, g, 1.0f, B.KN + (size_t)row * 512 + head * 64, 512, T); }
        } else {
            const int head = 4 * (pn - 5) + wc;
#pragma unroll
            for (int ai = 0; ai < 2; ++ai)
#pragma unroll
                for (int m = 0; m < 4; ++m) { const int row = row0 + ai * HALF + m * 16; const float r = rs_of(sv[ai][m], 1.0f / 128.0f); bf16_t* dst = B.VM + (size_t)row * 512 + head * 64;
                    tst16(T, 0, pack8(acc[ai][0][m][0] * r, acc[ai][0][m][1] * r), dst, 512); tst16(T, 1, pack8(acc[ai][1][m][0] * r, acc[ai][1][m][1] * r), dst + 32, 512); }
        }
    }
};

template <class Epi, class Sched, bool ALIGN_EPI = false, bool SP2 = false>
__device__ __forceinline__ void gemm_phase(PG8_LAS unsigned char* lds, const Gemm g, const Sched& S, const Epi& E) {
    const int tid = threadIdx.x, wid = __builtin_amdgcn_readfirstlane(tid >> 6), lane = tid & 63, wr = wid >> 2, wc = wid & 3, fr = lane & 15, fq = lane >> 4;
    const int K = g.K;
    unsigned voffA[2], voffB[2];
#pragma unroll
    for (int i = 0; i < 2; ++i) { int R, C; stage_rc(tid * 16 + i * 8192, R, C); const int Rb = Epi::PERM ? ((R & ~31) + perm32(R & 31)) : R;
        voffA[i] = (unsigned)(R * K + C) * 2u; voffB[i] = (unsigned)(Rb * K + C) * 2u; }
    const size_t kstep = (size_t)(BK * 2);
    const size_t hstep = (size_t)HALF * K * 2;
    const size_t tstep = 2 * hstep;
    const unsigned ldsw = (unsigned)wid * 1024u;
    const int aoff = lds_byte(wr * 64 + fr, fq * 8), boff = lds_byte(wc * 32 + fr, fq * 8);
#define PG8_SA(b, h) (((b) * 2 + (h)) * HTB)
#define PG8_SB(b, h) ((4 + (b) * 2 + (h)) * HTB)
#define PG8_STAGE(bufoff, gbase, voff) do { _Pragma("unroll") for (int _i = 0; _i < 2; ++_i) \
        __builtin_amdgcn_global_load_lds((const unsigned*)((const char*)(gbase) + (voff)[_i]), (PG8_LAS unsigned*)(lds + (bufoff) + ldsw + _i * 8192), 16, 0, 0); } while (0)
#define PG8_LDA(dst, b, h) do { _Pragma("unroll") for (int m = 0; m < 4; ++m) _Pragma("unroll") for (int k = 0; k < 2; ++k) dst[m][k] = *(const PG8_LAS bf16x8*)(lds + PG8_SA(b, h) + aoff + m * 2048 + k * 1024); } while (0)
#define PG8_LDB(dst, b, h) do { _Pragma("unroll") for (int n = 0; n < 2; ++n) _Pragma("unroll") for (int k = 0; k < 2; ++k) dst[n][k] = *(const PG8_LAS bf16x8*)(lds + PG8_SB(b, h) + boff + n * 2048 + k * 1024); } while (0)
#define PG8_MMA(ai, bj, At, Bt) do { __builtin_amdgcn_s_setprio(1); _Pragma("unroll") for (int m = 0; m < 4; ++m) _Pragma("unroll") for (int n = 0; n < 2; ++n) _Pragma("unroll") for (int k = 0; k < 2; ++k) \
        acc[ai][bj][m][n] = __builtin_amdgcn_mfma_f32_16x16x32_bf16(Bt[n][k], At[m][k], acc[ai][bj][m][n], 0, 0, 0); __builtin_amdgcn_s_setprio(0); } while (0)
#define PG8_WAIT_V(n) asm volatile("s_waitcnt vmcnt(" #n ")" ::: "memory")
#define PG8_WAIT_L(n) asm volatile("s_waitcnt lgkmcnt(" #n ")" ::: "memory")
#define PG8_BAR __builtin_amdgcn_s_barrier()
#define PG8_SCHED __builtin_amdgcn_sched_barrier(0)
    Unit cur, nxt; int ui = 0;
    if (!S.next(0, cur)) return;
    f32x4 acc[2][2][4][2];
#pragma unroll
    for (int a = 0; a < 2; ++a)
#pragma unroll
        for (int b = 0; b < 2; ++b)
#pragma unroll
            for (int m = 0; m < 4; ++m)
#pragma unroll
                for (int n = 0; n < 2; ++n) acc[a][b][m][n] = (f32x4){0.f, 0.f, 0.f, 0.f};
    bf16x8 At[4][2], B0[2][2], B1[2][2];
    const char* cA = (const char*)g.A + (size_t)cur.pm * tstep + cur.koff; const char* cB = (const char*)g.Bt + (size_t)cur.pn * tstep + cur.koff;
    S.a_ready(cur);
    if constexpr (SP2) {
        PG8_STAGE(PG8_SB(0, 0), cB, voffB); PG8_STAGE(PG8_SB(0, 1), cB + hstep, voffB); PG8_STAGE(PG8_SA(0, 0), cA, voffA); PG8_STAGE(PG8_SA(0, 1), cA + hstep, voffA);
        if (wr == 1) PG8_BAR;
        PG8_WAIT_V(2); PG8_BAR;
        PG8_STAGE(PG8_SB(1, 0), cB + kstep, voffB); PG8_STAGE(PG8_SA(1, 0), cA + kstep, voffA); PG8_STAGE(PG8_SB(1, 1), cB + hstep + kstep, voffB);
        PG8_WAIT_V(6); PG8_BAR;
    } else {
        PG8_STAGE(PG8_SB(0, 0), cB, voffB); PG8_STAGE(PG8_SA(0, 0), cA, voffA); PG8_STAGE(PG8_SB(0, 1), cB + hstep, voffB); PG8_STAGE(PG8_SA(0, 1), cA + hstep, voffA);
        if (wr == 1) PG8_BAR;
        PG8_WAIT_V(4); PG8_BAR;
        PG8_STAGE(PG8_SB(1, 0), cB + kstep, voffB); PG8_STAGE(PG8_SA(1, 0), cA + kstep, voffA); PG8_STAGE(PG8_SB(1, 1), cB + hstep + kstep, voffB);
        PG8_WAIT_V(6); PG8_BAR;
    }
    for (;;) {
        const bool has_next = S.next(ui + 1, nxt);
        const char* nA = has_next ? (const char*)g.A + (size_t)nxt.pm * tstep + nxt.koff : cA; const char* nB = has_next ? (const char*)g.Bt + (size_t)nxt.pn * tstep + nxt.koff : cB;
        const int nt = cur.nt;
#pragma unroll 1
        for (int t = 0; t < nt; t += 2) {
            const bool last = (t == nt - 2);
            const char* a1 = cA + (size_t)(t + 1) * kstep;
            const char* a2 = last ? nA : cA + (size_t)(t + 2) * kstep; const char* b2 = last ? nB : cB + (size_t)(t + 2) * kstep;
            const char* a3 = a2 + kstep; const char* b3 = b2 + kstep;
            if (last && has_next) S.a_ready(nxt);
            if constexpr (SP2) {
            PG8_LDB(B0, 0, 0); PG8_LDB(B1, 0, 1); PG8_SCHED; PG8_LDA(At, 0, 0); PG8_STAGE(PG8_SA(1, 1), a1 + hstep, voffA);
            PG8_WAIT_V(8); PG8_WAIT_L(0); PG8_BAR; PG8_MMA(0, 0, At, B0); PG8_MMA(0, 1, At, B1); PG8_BAR; PG8_SCHED;
            PG8_LDA(At, 0, 1); PG8_STAGE(PG8_SB(0, 0), b2, voffB); PG8_STAGE(PG8_SB(0, 1), b2 + hstep, voffB); PG8_STAGE(PG8_SA(0, 0), a2, voffA);
            PG8_WAIT_V(8); PG8_WAIT_L(0); PG8_BAR; PG8_MMA(1, 0, At, B0); PG8_MMA(1, 1, At, B1); PG8_BAR; PG8_SCHED;
            PG8_LDB(B0, 1, 0); PG8_LDB(B1, 1, 1); PG8_SCHED; PG8_LDA(At, 1, 0); PG8_STAGE(PG8_SA(0, 1), a2 + hstep, voffA);
            PG8_WAIT_V(8); PG8_WAIT_L(0); PG8_BAR; PG8_MMA(0, 0, At, B0); PG8_MMA(0, 1, At, B1); PG8_BAR; PG8_SCHED;
            PG8_LDA(At, 1, 1); PG8_STAGE(PG8_SB(1, 0), b3, voffB); PG8_STAGE(PG8_SB(1, 1), b3 + hstep, voffB); PG8_STAGE(PG8_SA(1, 0), a3, voffA);
            PG8_WAIT_V(8); PG8_WAIT_L(0); PG8_BAR; PG8_MMA(1, 0, At, B0); PG8_MMA(1, 1, At, B1); PG8_BAR; PG8_SCHED;
            } else {
            PG8_LDB(B0, 0, 0); PG8_SCHED; PG8_LDA(At, 0, 0); PG8_STAGE(PG8_SA(1, 1), a1 + hstep, voffA);
            PG8_WAIT_L(8); PG8_BAR; PG8_WAIT_L(0); PG8_MMA(0, 0, At, B0); PG8_BAR; PG8_SCHED;
            PG8_LDB(B1, 0, 1); PG8_STAGE(PG8_SB(0, 0), b2, voffB);
            PG8_BAR; PG8_WAIT_L(0); PG8_MMA(0, 1, At, B1); PG8_BAR;
            PG8_LDA(At, 0, 1); PG8_STAGE(PG8_SA(0, 0), a2, voffA);
            PG8_BAR; PG8_WAIT_L(0); PG8_MMA(1, 0, At, B0); PG8_BAR; PG8_SCHED;
            PG8_STAGE(PG8_SB(0, 1), b2 + hstep, voffB);
            PG8_WAIT_V(6); PG8_BAR; PG8_MMA(1, 1, At, B1); PG8_BAR;
            PG8_LDB(B0, 1, 0); PG8_SCHED; PG8_LDA(At, 1, 0); PG8_STAGE(PG8_SA(0, 1), a2 + hstep, voffA);
            PG8_WAIT_L(8); PG8_BAR; PG8_WAIT_L(0); PG8_MMA(0, 0, At, B0); PG8_BAR; PG8_SCHED;
            PG8_LDB(B1, 1, 1); PG8_STAGE(PG8_SB(1, 0), b3, voffB);
            PG8_BAR; PG8_WAIT_L(0); PG8_MMA(0, 1, At, B1); PG8_BAR;
            PG8_LDA(At, 1, 1); PG8_STAGE(PG8_SA(1, 0), a3, voffA);
            PG8_BAR; PG8_WAIT_L(0); PG8_MMA(1, 0, At, B0); PG8_BAR; PG8_SCHED;
            PG8_STAGE(PG8_SB(1, 1), b3 + hstep, voffB);
            PG8_WAIT_V(6); PG8_BAR; PG8_MMA(1, 1, At, B1); PG8_BAR;
            }
        }
        if constexpr (ALIGN_EPI) { if (wr == 0) PG8_BAR; }
        if constexpr (!Epi::AFTER_DRAIN) { E(acc, cur, wr, wc, fr, fq); S.done(cur); }
        if (!has_next) break;
#pragma unroll
        for (int a = 0; a < 2; ++a)
#pragma unroll
            for (int b = 0; b < 2; ++b)
#pragma unroll
                for (int m = 0; m < 4; ++m)
#pragma unroll
                    for (int n = 0; n < 2; ++n) acc[a][b][m][n] = (f32x4){0.f, 0.f, 0.f, 0.f};
        cur = nxt; cA = nA; cB = nB; ++ui;
        if constexpr (ALIGN_EPI) { if (wr == 1) PG8_BAR; }
    }
    PG8_WAIT_V(0);
    if constexpr (!ALIGN_EPI) { if (wr == 0) PG8_BAR; }
    PG8_BAR;
#undef PG8_SA
#undef PG8_SB
#undef PG8_STAGE
#undef PG8_LDA
#undef PG8_LDB
#undef PG8_MMA
#undef PG8_WAIT_V
#undef PG8_WAIT_L
#undef PG8_BAR
#undef PG8_SCHED
}
}

namespace att {
using bf16x8 = __attribute__((ext_vector_type(8))) short;
using s16x4 = __attribute__((ext_vector_type(4))) short;
using f32x16 = __attribute__((ext_vector_type(16))) float;
using u32x4 = __attribute__((ext_vector_type(4))) unsigned;
typedef unsigned short bf16_t;
typedef __attribute__((address_space(3))) const char* lds_cptr;
typedef __attribute__((address_space(3))) char* lds_ptr;
typedef __attribute__((address_space(3))) float* lds_fptr;
typedef short v4i16_t __attribute__((ext_vector_type(4)));
constexpr int SEQ = 2048, QB = 256, KVBLK = 64;
constexpr int KBUF = 12288, VBUF = 8192, LDS_K = 0, LDS_V = 2 * KBUF, LDS_WS = LDS_V + 2 * VBUF, LDS_OST = LDS_WS + 8 * 256, LDS_BYTES = LDS_OST + 8 * 4096;
constexpr float THR = 8.0f, LOG2E_A = 1.4426950408889634f;
__device__ __forceinline__ int crow(int r, int hi) { return (r & 3) + 8 * (r >> 2) + 4 * hi; }
__device__ __forceinline__ void glds16(const void* gsrc, unsigned lds_dst) { unsigned keep;
    asm volatile("s_mov_b32 %0, m0\n\ts_mov_b32 m0, %2\n\ts_nop 0\n\tglobal_load_lds_dwordx4 %1, off\n\ts_mov_b32 m0, %0" : "=&s"(keep) : "v"(gsrc), "s"(lds_dst) : "memory"); }
typedef float f32x2_t __attribute__((ext_vector_type(2))); typedef __bf16 bf16x2_t __attribute__((ext_vector_type(2)));
__device__ __forceinline__ unsigned cvtpk(float lo, float hi) { f32x2_t v = {lo, hi}; bf16x2_t b = __builtin_convertvector(v, bf16x2_t); return __builtin_bit_cast(unsigned, b); }
__device__ __forceinline__ s16x4 vtr(lds_cptr p) { return __builtin_bit_cast(s16x4, __builtin_amdgcn_ds_read_tr16_b64_v4i16((__attribute__((address_space(3))) v4i16_t*)p)); }
__device__ __forceinline__ float fadd_s(float a, float b) { float r = a + b; asm("" : "+v"(r)); return r; }
#define ATT_MX3(a, b, c) __builtin_fmaxf(__builtin_fmaxf((a), (b)), (c))
__device__ __forceinline__ float rowmax(const f32x16& p0, const f32x16& p1) {
    float a = ATT_MX3(p0[0], p0[1], p1[0]), b = ATT_MX3(p0[2], p0[3], p1[1]); a = ATT_MX3(a, p1[2], p1[3]);
#pragma unroll
    for (int r = 4; r < 16; r += 4) { a = ATT_MX3(a, p0[r], p0[r + 1]); b = ATT_MX3(b, p0[r + 2], p0[r + 3]); a = ATT_MX3(a, p1[r], p1[r + 1]); b = ATT_MX3(b, p1[r + 2], p1[r + 3]); }
    float m = __builtin_fmaxf(a, b); auto rr = __builtin_amdgcn_permlane32_swap(__float_as_uint(m), __float_as_uint(m), false, false);
    return __builtin_fmaxf(__uint_as_float(rr[0]), __uint_as_float(rr[1])); }

__device__ __forceinline__ void glds16s(const void* sbase_, unsigned voff, unsigned lds_dst) { unsigned keep;
    const unsigned long long a_ = (unsigned long long)sbase_; const unsigned long long sbase = ((unsigned long long)(unsigned)__builtin_amdgcn_readfirstlane((int)(a_ >> 32)) << 32) | (unsigned)__builtin_amdgcn_readfirstlane((int)a_);
    asm volatile("s_nop 4\n\ts_mov_b32 %0, m0\n\ts_mov_b32 m0, %3\n\ts_nop 0\n\tglobal_load_lds_dwordx4 %1, %2\n\ts_mov_b32 m0, %0" : "=&s"(keep) : "v"(voff), "s"(sbase), "s"(lds_dst) : "memory"); }

struct Bufs { const bf16_t* Q; const bf16_t* K; const bf16_t* KPE; const bf16_t* V; bf16_t* O; };
struct USel { long rowbase; int q0, t0, t1, qcol, kcol, ocol, head0; };

template <bool SWA>
__device__ __forceinline__ void att_phase(const int u0, const int NU, const Bufs B, char* shm, const float* sink) {
    constexpr int ND0 = SWA ? 4 : 6, QP = SWA ? 512 : 768, KP = SWA ? 128 : 512, VP = KP;
    int tid = threadIdx.x; asm volatile("" : "+v"(tid));
    const int lane = tid & 63, r32 = lane & 31, hi = lane >> 5; const int wid = __builtin_amdgcn_readfirstlane(tid >> 6);
    const int hsub = SWA ? (wid & 3) : 0, wrow = SWA ? (wid >> 2) * 32 : wid * 32;
    const unsigned lds0 = (unsigned)(uintptr_t)shm;
    const lds_cptr shm3 = (lds_cptr)shm;
    lds_fptr wsf = (lds_fptr)((lds_ptr)shm + LDS_WS) + wid * 64;
    const unsigned koff = (unsigned)((lane * KP + wid * 8) * 2), peoff = (unsigned)((lane * 32 + wid * 8) * 2);
    const unsigned voff = (unsigned)(((16 * (wid & 3) + (lane >> 2)) * VP + (wid >> 2) * 32 + (lane & 3) * 8) * 2);
    const unsigned kdst = lds0 + LDS_K + wid * 1024, pedst = lds0 + LDS_K + (8 + wid) * 1024, vdst = lds0 + LDS_V + wid * 1024;
    const lds_cptr kp0 = shm3 + LDS_K + hi * 1024 + r32 * 16;
    const lds_cptr vp0 = shm3 + LDS_V + ((lane >> 4) & 1) * 32 + (lane & 3) * 8 + (4 * hi + ((lane & 15) >> 2)) * 64;
    auto decode = [&](int u) { USel s;
        if (SWA) { const int rb = u & 31, kvh = (u >> 5) & 1, b = u >> 6; s.rowbase = (long)b * SEQ; s.q0 = rb * 64; s.t0 = rb - 2 < 0 ? 0 : rb - 2; s.t1 = rb + 3 > SEQ / KVBLK ? SEQ / KVBLK : rb + 3;
                   s.qcol = kvh * 256; s.kcol = kvh * 64; s.ocol = 512 + kvh * 256; s.head0 = kvh * 4; }
        else { const int qb = u & 7, h = (u >> 3) & 7, b = u >> 6; s.rowbase = (long)b * SEQ; s.q0 = qb * QB; s.t0 = 0; s.t1 = SEQ / KVBLK; s.qcol = h * 96; s.kcol = h * 64; s.ocol = h * 64; s.head0 = h; }
        return s; };
#define ATT_DMA(s, t, slot) do { glds16s(B.K + ((s).rowbase + (long)(t) * KVBLK) * KP + (s).kcol, koff, (unsigned)__builtin_amdgcn_readfirstlane(kdst + (slot) * KBUF)); \
        if (!SWA && wid < 4) glds16s(B.KPE + ((s).rowbase + (long)(t) * KVBLK) * 32, peoff, (unsigned)__builtin_amdgcn_readfirstlane(pedst + (slot) * KBUF)); \
        glds16s(B.V + ((s).rowbase + (long)(t) * KVBLK) * VP + (s).kcol, voff, (unsigned)__builtin_amdgcn_readfirstlane(vdst + (slot) * VBUF)); } while (0)
#define ATT_WAIT_BAR() asm volatile("s_waitcnt vmcnt(0) lgkmcnt(0)\n\ts_barrier" ::: "memory")
#define ATT_LOADQ(s) do { const bf16_t* Qw_ = B.Q + ((s).rowbase + (s).q0 + wrow + r32) * QP + (s).qcol + hsub * 64 + hi * 8; \
        _Pragma("unroll") for (int d0 = 0; d0 < ND0; ++d0) qr[d0] = *reinterpret_cast<const bf16x8*>(Qw_ + d0 * 16); } while (0)
    USel cur = decode(u0);
    int slot = 0;
    bf16x8 qr[ND0];
    ATT_DMA(cur, cur.t0, 0);
    ATT_LOADQ(cur);
#pragma unroll 1
    for (int iu = 0; iu < NU; ++iu) {
        const bool has_next = iu + 1 < NU;
        const USel nxt = decode(has_next ? u0 + iu + 1 : u0 + iu);
        const int w0 = cur.q0 + wrow;
        const float slope2 = SWA ? LOG2E_A * __builtin_amdgcn_exp2f(-(float)(cur.head0 + hsub + 1)) : 0.f;
        const float sink2 = SWA ? sink[cur.head0 + hsub] * LOG2E_A : 0.f;
        float mhat = SWA ? sink2 : 0.f, l_reg = SWA ? (hi == 0 ? 1.f : 0.f) : 0.f;
        f32x16 o[2]; o[0] = f32x16{}; o[1] = f32x16{};
        f32x16 negm;
#pragma unroll
        for (int r = 0; r < 16; ++r) negm[r] = -mhat;
        asm volatile("" : "+v"(negm));
        ATT_WAIT_BAR();
        for (int t = cur.t0; t < cur.t1; ++t) {
            const bool active = !SWA || ((t * 64 + 63 >= w0 - 128) && (t * 64 <= w0 + 31 + 128));
            bf16x8 kf[2 * ND0];
            if (active) { const lds_cptr kp = kp0 + slot * KBUF;
#pragma unroll
                for (int d0 = 0; d0 < ND0; ++d0) { kf[2 * d0] = *(const __attribute__((address_space(3))) bf16x8*)(kp + d0 * 2048); kf[2 * d0 + 1] = *(const __attribute__((address_space(3))) bf16x8*)(kp + d0 * 2048 + 512); } }
            __builtin_amdgcn_sched_barrier(0);
            if (t + 1 < cur.t1) ATT_DMA(cur, t + 1, slot ^ 1); else if (has_next) ATT_DMA(nxt, nxt.t0, slot ^ 1);
            if (active) {
                f32x16 p0, p1;
                __builtin_amdgcn_sched_barrier(0);
#pragma unroll
                for (int d0 = 0; d0 < ND0; ++d0) {
                    p0 = __builtin_amdgcn_mfma_f32_32x32x16_bf16(kf[2 * d0], qr[d0], d0 == 0 ? negm : p0, 0, 0, 0);
                    p1 = __builtin_amdgcn_mfma_f32_32x32x16_bf16(kf[2 * d0 + 1], qr[d0], d0 == 0 ? negm : p1, 0, 0, 0);
                }
                __builtin_amdgcn_sched_barrier(0);
                const lds_cptr vp = vp0 + slot * VBUF;
                s16x4 vlo[8], vhi[8];
#pragma unroll
                for (int i = 0; i < 8; ++i) { vlo[i] = vtr(vp + (i >> 2) * 4096 + (i & 3) * 1024); vhi[i] = vtr(vp + (i >> 2) * 4096 + (i & 3) * 1024 + 512); }
                __builtin_amdgcn_sched_barrier(0);
                if (SWA) {
                    const float qf = (float)(w0 + r32 - t * 64 - 4 * hi);
#pragma unroll
                    for (int r = 0; r < 16; ++r) { const float d0 = (float)((r & 3) + 8 * (r >> 2)) - qf, d1 = d0 + 32.0f;
                        p0[r] = (__builtin_fabsf(d0) <= 128.0f) ? __builtin_fmaf(-slope2, __builtin_fabsf(d0), p0[r]) : -INFINITY;
                        p1[r] = (__builtin_fabsf(d1) <= 128.0f) ? __builtin_fmaf(-slope2, __builtin_fabsf(d1), p1[r]) : -INFINITY; }
                }
                const float rm = rowmax(p0, p1);
                const bool first = !SWA && (t == cur.t0);
                if (first || __any(rm > THR)) {
                    const float dl = first ? rm : __builtin_fmaxf(rm, 0.f);
                    mhat += dl;
#pragma unroll
                    for (int r = 0; r < 16; ++r) { p0[r] -= dl; p1[r] -= dl; }
#pragma unroll
                    for (int r = 0; r < 16; ++r) negm[r] = -mhat;
                    asm volatile("" : "+v"(negm));
                    const float f = __builtin_amdgcn_exp2f(-dl); l_reg *= f;
                    if (!first) {
                        if (hi == 0) wsf[r32] = f;
#pragma unroll
                        for (int r = 0; r < 16; ++r) { const float fr_ = wsf[crow(r, hi)]; o[0][r] *= fr_; o[1][r] *= fr_; }
                    }
                }
#pragma unroll
                for (int r = 0; r < 16; ++r) { p0[r] = __builtin_amdgcn_exp2f(p0[r]); p1[r] = __builtin_amdgcn_exp2f(p1[r]); }
                float sa = fadd_s(p0[0], p0[1]), sb = fadd_s(p1[0], p1[1]);
#pragma unroll
                for (int r = 2; r < 16; ++r) { sa = fadd_s(sa, p0[r]); sb = fadd_s(sb, p1[r]); }
                l_reg += fadd_s(sa, sb);
                u32x4 pw[4];
#pragma unroll
                for (int j = 0; j < 4; ++j) { pw[0][j] = cvtpk(p0[2 * j], p0[2 * j + 1]); pw[1][j] = cvtpk(p0[8 + 2 * j], p0[9 + 2 * j]); pw[2][j] = cvtpk(p1[2 * j], p1[2 * j + 1]); pw[3][j] = cvtpk(p1[8 + 2 * j], p1[9 + 2 * j]); }
#pragma unroll
                for (int d0 = 0; d0 < 2; ++d0)
#pragma unroll
                    for (int ks = 0; ks < 4; ++ks) { const s16x4 lo = vlo[d0 * 4 + ks], hh = vhi[d0 * 4 + ks];
                        const bf16x8 vf = (bf16x8){lo[0], lo[1], lo[2], lo[3], hh[0], hh[1], hh[2], hh[3]};
                        o[d0] = __builtin_amdgcn_mfma_f32_32x32x16_bf16(__builtin_bit_cast(bf16x8, pw[ks]), vf, o[d0], 0, 0, 0); }
            }
            if (t + 1 < cur.t1) ATT_WAIT_BAR();
            slot ^= 1;
        }
        if (has_next) ATT_LOADQ(nxt);
        { auto rr = __builtin_amdgcn_permlane32_swap(__float_as_uint(l_reg), __float_as_uint(l_reg), false, false); l_reg = __uint_as_float(rr[0]) + __uint_as_float(rr[1]); }
        if (hi == 0) wsf[32 + r32] = l_reg;
        float rli[16];
#pragma unroll
        for (int r = 0; r < 16; ++r) rli[r] = __builtin_amdgcn_rcpf(wsf[32 + crow(r, hi)]);
        {
            __attribute__((address_space(3))) bf16_t* stg = (__attribute__((address_space(3))) bf16_t*)((lds_ptr)shm + LDS_OST) + wid * 2048;
#pragma unroll
            for (int r = 0; r < 16; ++r) { const int orow = crow(r, hi);
#pragma unroll
                for (int d0 = 0; d0 < 2; ++d0) { const float v = o[d0][r] * rli[r]; stg[orow * 64 + d0 * 32 + r32] = (bf16_t)(cvtpk(v, v) & 0xffffu); } }
            bf16_t* Ow = B.O + (cur.rowbase + w0) * 1024 + cur.ocol + hsub * 64;
#pragma unroll
            for (int i = 0; i < 4; ++i) { const int row = i * 8 + (lane >> 3), ch = lane & 7; const u32x4 v = *(const __attribute__((address_space(3))) u32x4*)(stg + row * 64 + ch * 8); *(u32x4*)(Ow + (long)row * 1024 + ch * 8) = v; }
        }
        cur = nxt;
    }
    ATT_WAIT_BAR();
#undef ATT_DMA
#undef ATT_WAIT_BAR
#undef ATT_LOADQ
}
}

constexpr int NWAVES = 8;
constexpr int N_LAUNCHES = MK_N_LAUNCHES;
constexpr int PER_PHASE = 9;
constexpr int BATCH = 16, SEQ = 2048, D = 1024, FF = 2816, M = BATCH * SEQ;
constexpr int NGU = 2 * FF  , NWIN = 1280, NUP = 1792, KUP = 384;

constexpr size_t MiB = 1u << 20;
constexpr size_t WS_CTL = 0, CTL_ZERO_BYTES = 1 * MiB;
constexpr size_t WS_SS1 = 256 * 1024, WS_SS2 = 384 * 1024, WS_SSQ = 512 * 1024, WS_SSKV = 640 * 1024, WS_SS0 = 768 * 1024;
constexpr size_t WS_ROPE = 1 * MiB;
constexpr size_t WS_W1GU = 2 * MiB, WS_W1D = 13 * MiB, WS_W2GU = 19 * MiB, WS_W2D = 30 * MiB, WS_WIN = 36 * MiB, WS_WUP = 39 * MiB, WS_WO = 41 * MiB;
constexpr size_t WS_XB = 48 * MiB;
constexpr size_t WS_HID = 112 * MiB;
constexpr size_t WS_HQKV = 112 * MiB, WS_KPE = 136 * MiB, WS_SQ = 138 * MiB, WS_SK = 170 * MiB, WS_SV = 178 * MiB, WS_QM = 186 * MiB, WS_KN = 234 * MiB, WS_VM = 266 * MiB;
constexpr size_t WS_Y = 298 * MiB, WS_END = 362 * MiB;
static_assert(WS_HID + (size_t)M * FF * 2 <= WS_Y && WS_VM + (size_t)M * 512 * 2 <= WS_Y && WS_Y + (size_t)M * D * 2 <= WS_END, "d_ws map");
static_assert(WS_W1GU + (size_t)NGU * D * 2 <= WS_W1D && WS_W1D + (size_t)D * FF * 2 <= WS_W2GU && WS_W2GU + (size_t)NGU * D * 2 <= WS_W2D && WS_W2D + (size_t)D * FF * 2 <= WS_WIN &&
              WS_WIN + (size_t)NWIN * D * 2 <= WS_WUP && WS_WUP + (size_t)NUP * KUP * 2 <= WS_WO && WS_WO + (size_t)D * D * 2 <= WS_XB, "weight map");
constexpr int CW_BAR = 4096;

constexpr int RING_OFF = 0, RING_BYTES = 131072;
constexpr int LDSCTL_OFF = RING_BYTES, MISC_OFF = LDSCTL_OFF + 320;
constexpr int LDS_BYTES = 147456;
static_assert(MISC_OFF + 128 <= LDS_BYTES && att::LDS_BYTES <= RING_BYTES, "LDS map");

#define GAS __attribute__((address_space(1)))
#define LAS __attribute__((address_space(3)))
typedef unsigned short bf16;
typedef unsigned v4u __attribute__((ext_vector_type(4)));
typedef float f32x4 __attribute__((ext_vector_type(4)));
typedef GAS unsigned gu32;
#define RLX_AGENT __ATOMIC_RELAXED, __HIP_MEMORY_SCOPE_AGENT
#define LDS_WAIT() asm volatile("s_waitcnt lgkmcnt(0)" ::: "memory")
#define VM_WAIT() asm volatile("s_waitcnt vmcnt(0)" ::: "memory")
__device__ __forceinline__ unsigned f2bf(float f) { unsigned u = __builtin_bit_cast(unsigned, f); return (u + 0x7fffu + ((u >> 16) & 1u)) >> 16; }
__device__ __forceinline__ unsigned pk2(float lo, float hi) { return f2bf(lo) | (f2bf(hi) << 16); }

#define XB_TMO      128
#define XB_XCNT(j)  (256  + 64 * (j))
#define XB_XSUB(j)  (1280 + 64 * (j))
#define XB_XGEN(j)  (2304 + 64 * (j))
#define XB_TOP      3328
#define XB_TOPGEN   3392
#define XCD_BAR_WORDS 3456
#define XB_SPIN_CAP (1u << 18)
__device__ __forceinline__ unsigned xb_ld(unsigned* p)              { return __hip_atomic_load(p, __ATOMIC_RELAXED, __HIP_MEMORY_SCOPE_AGENT); }
__device__ __forceinline__ unsigned xb_add(unsigned* p, unsigned v) { return __hip_atomic_fetch_add(p, v, __ATOMIC_RELAXED, __HIP_MEMORY_SCOPE_AGENT); }
__device__ __forceinline__ unsigned xb_xcc_id() { return (unsigned)__builtin_amdgcn_s_getreg((3 << 11) | 20) & 0xFu; }
#define XB_SPIN(cond, bar) do { unsigned _sp = 0; while (cond) { __builtin_amdgcn_s_sleep(1); \
    if ((++_sp & 255u) == 0u) { if (xb_ld(&(bar)[XB_TMO])) break; if (_sp > XB_SPIN_CAP) { atomicAdd(&(bar)[XB_TMO], 1u); break; } } } } while (0)
struct XcdBarrier { unsigned* bar; unsigned x; volatile LAS unsigned* st; };
__device__ __forceinline__ XcdBarrier xcd_barrier_post(unsigned* bar, volatile LAS unsigned* st) {
    XcdBarrier b; b.bar = bar; b.x = xb_xcc_id(); b.st = st;
    if (threadIdx.x == 0) (void)xb_add(&bar[XB_XCNT(b.x)], 1u);
    return b;
}
__device__ __forceinline__ void xcd_barrier_complete(unsigned* bar, unsigned x, unsigned& nloc, unsigned& nx) {
    const unsigned G = gridDim.x * gridDim.y * gridDim.z;
    unsigned sum, cnt, mine, sp = 0u;
    for (;;) {
        sum = 0u; cnt = 0u; mine = 0u;
#pragma unroll
        for (unsigned j = 0; j < 16; ++j) { const unsigned c = xb_ld(&bar[XB_XCNT(j)]); sum += c; cnt += (c > 0u) ? 1u : 0u; mine = (j == x) ? c : mine; }
        if (sum == G) break;
        __builtin_amdgcn_s_sleep(1);
        if ((++sp & 255u) == 0u) { if (xb_ld(&bar[XB_TMO])) break; if (sp > XB_SPIN_CAP) { atomicAdd(&bar[XB_TMO], 1u); break; } }
    }
    nloc = mine > 0u ? mine : 1u; nx = cnt > 0u ? cnt : 1u;
}
__device__ __forceinline__ void xcd_barrier(const XcdBarrier& b) {
    asm volatile("s_waitcnt vmcnt(0)" ::: "memory");
    __syncthreads();
    if (threadIdx.x == 0) {
        unsigned* bar = b.bar;
        __builtin_amdgcn_s_waitcnt(0);
        unsigned nloc = b.st[0], nx = b.st[1];
        if (nloc == 0u) { xcd_barrier_complete(bar, b.x, nloc, nx); b.st[0] = nloc; b.st[1] = nx; }
        const unsigned old = xb_add(&bar[XB_XSUB(b.x)], 1u);
        const unsigned gen = old / nloc;
        if (old + 1u == (gen + 1u) * nloc) {
            __builtin_amdgcn_fence(__ATOMIC_RELEASE, "agent");
            asm volatile("s_waitcnt vmcnt(0)" ::: "memory");
            const unsigned og = xb_add(&bar[XB_TOP], 1u);
            const unsigned tg = og / nx;
            if (og + 1u == (tg + 1u) * nx) xb_add(&bar[XB_TOPGEN], 1u);
            else XB_SPIN(xb_ld(&bar[XB_TOPGEN]) == tg, bar);
            __builtin_amdgcn_fence(__ATOMIC_ACQUIRE, "agent");
            xb_add(&bar[XB_XGEN(b.x)], 1u);
            asm volatile("s_waitcnt vmcnt(0)" ::: "memory");
        } else {
            XB_SPIN(xb_ld(&bar[XB_XGEN(b.x)]) == gen, bar);
            __builtin_amdgcn_fence(__ATOMIC_ACQUIRE, "agent");
            asm volatile("s_waitcnt vmcnt(0)" ::: "memory");
        }
    }
    __syncthreads();
}

__host__ __device__ __forceinline__ int rope_logical(int jj) { return 16 * ((jj >> 2) & 1) + 4 * (jj >> 3) + (jj & 3); }
__host__ __device__ __forceinline__ int win_src(int p) {
    const int pn = p >> 8, j = p & 255, bj = j >> 7, wc = (j >> 5) & 3, jj = j & 31;
    if (pn == 0) return j;
    if (pn == 1) { if (j < 128) return 256 + j; if (j < 160) return 384 + rope_logical(jj); return -1; }
    if (pn < 4) return 416 + (4 * (pn - 2) + wc) * 64 + 32 * bj + jj;
    return (wc < 2 ? 928 + wc * 64 : 1056 + (wc - 2) * 64) + 32 * bj + jj;
}
__host__ __device__ __forceinline__ int up_src(int p, bool& is_kv) {
    const int pn = p >> 8, j = p & 255, bj = j >> 7, wc = (j >> 5) & 3, jj = j & 31;
    if (pn < 2) { is_kv = false; return (4 * pn + wc) * 96 + 32 * bj + jj; }
    if (pn == 2) { is_kv = false; return (4 * bj + wc) * 96 + 64 + rope_logical(jj); }
    is_kv = true;
    if (pn < 5) return (4 * (pn - 3) + wc) * 128 + 32 * bj + jj;
    return (4 * (pn - 5) + wc) * 128 + 64 + 32 * bj + jj;
}

struct Frame {
    LAS unsigned char* lds;
    volatile LAS unsigned* MISC;
    gu32* ctl;
    int tid, lane, wave;
    int vcu, G;
};
struct Args { const float* in[23]; float* out; unsigned char* ws; int ph_lo, ph_hi, li, pad; };

__device__ __forceinline__ float wave_sum(float v) {
#pragma unroll
    for (int o = 1; o < 64; o <<= 1) v += __shfl_xor(v, o);
    return v;
}
__device__ __forceinline__ void p0_item(const float* W, int ldw, int ks0, const float* g, int col, bf16* dst, int Kp, LAS float* scr, int lane) {
    const bool z = (W == nullptr) || (col < 0);
    float wv[32];
#pragma unroll
    for (int i = 0; i < 32; ++i) { const int kk = 2 * i + (lane >> 5); wv[i] = z ? 0.f : W[(size_t)(ks0 + kk) * ldw + col]; }
#pragma unroll
    for (int i = 0; i < 32; ++i) { const int kk = 2 * i + (lane >> 5); float v = wv[i]; if (!z && g) v *= g[ks0 + kk]; scr[kk * 33 + (lane & 31)] = v; }
    LDS_WAIT(); asm volatile("" ::: "memory");
    const int c = lane & 7;
#pragma unroll
    for (int j = 0; j < 4; ++j) { const int n = (lane >> 3) + 8 * j; const LAS float* s = scr + (8 * c) * 33 + n;
        v4u o; o.x = pk2(s[0 * 33], s[1 * 33]); o.y = pk2(s[2 * 33], s[3 * 33]); o.z = pk2(s[4 * 33], s[5 * 33]); o.w = pk2(s[6 * 33], s[7 * 33]);
        *(GAS v4u*)(dst + (size_t)n * Kp + 8 * c) = o; }
    LDS_WAIT(); asm volatile("" ::: "memory");
}

__device__ __forceinline__ void convert_weights(Frame& F, const Args& a, int set, int worker, int nworkers) {
    LAS float* scr = (LAS float*)(F.lds + RING_OFF + F.wave * 16384);
    const int lane = F.lane; unsigned char* ws = a.ws;
    constexpr int I_GU = 16 * 176, I_D = 44 * 32, I_WIN = 16 * 40, I_UP = 6 * 56, I_WO = 16 * 32;
    const int nitems = set == 0 ? I_GU + I_D + I_WIN + I_UP : I_GU + I_D + I_WO;
    for (int it = worker; it < nitems; it += nworkers) {
        int r = it; const int f = set;
        if (r < I_GU) { const int kb = r / 176, nb = r % 176, p = nb * 32 + (lane & 31);
            const float* W = ((p >> 7) & 1) ? a.in[f ? 21 : 3] : a.in[f ? 20 : 2]; const int col = 128 * (p >> 8) + (p & 127);
            p0_item(W, FF, kb * 64, a.in[f ? 19 : 1], col, (bf16*)(ws + (f ? WS_W2GU : WS_W1GU)) + (size_t)(nb * 32) * D + kb * 64, D, scr, lane); continue; }
        r -= I_GU;
        if (r < I_D) { const int kb = r / 32, nb = r % 32;
            p0_item(a.in[f ? 22 : 4], D, kb * 64, nullptr, nb * 32 + (lane & 31), (bf16*)(ws + (f ? WS_W2D : WS_W1D)) + (size_t)(nb * 32) * FF + kb * 64, FF, scr, lane); continue; }
        r -= I_D;
        if (set == 1) { const int kb = r / 32, nb = r % 32;
            p0_item(a.in[18], D, kb * 64, nullptr, nb * 32 + (lane & 31), (bf16*)(ws + WS_WO) + (size_t)(nb * 32) * D + kb * 64, D, scr, lane); continue; }
        if (r < I_WIN) { const int kb = r / 40, nb = r % 40;
            p0_item(a.in[6], 1184, kb * 64, a.in[5], win_src(nb * 32 + (lane & 31)), (bf16*)(ws + WS_WIN) + (size_t)(nb * 32) * D + kb * 64, D, scr, lane); continue; }
        r -= I_WIN;
        { const int kb = r / 56, nb = r % 56; bool kv; const int col = up_src(nb * 32 + (lane & 31), kv);
            const bool live = kv ? (kb >= 4) : (kb < 4);
            p0_item(live ? (kv ? a.in[10] : a.in[8]) : nullptr, kv ? 1024 : 768, kv ? (kb - 4) * 64 : kb * 64, kv ? a.in[9] : a.in[7], col, (bf16*)(ws + WS_WUP) + (size_t)(nb * 32) * KUP + kb * 64, KUP, scr, lane); }
    }
}

__device__ __forceinline__ void p0_prologue(Frame& F, const Args& a) {
    const int gw = F.vcu * NWAVES + F.wave, NGW = F.G * NWAVES, lane = F.lane;
    unsigned char* ws = a.ws;
    convert_weights(F, a, 0, gw, NGW);
    const float* x = a.in[0]; bf16* XB = (bf16*)(ws + WS_XB); float* ss0 = (float*)(ws + WS_SS0);
    for (int m0 = gw * 4; m0 < M; m0 += NGW * 4) {
        f32x4 v[4][4];
#pragma unroll
        for (int q = 0; q < 4; ++q) { const GAS f32x4* xr = (const GAS f32x4*)(x + (size_t)(m0 + q) * D) + 2 * lane;
#pragma unroll
            for (int j = 0; j < 2; ++j) { v[q][2 * j] = __builtin_nontemporal_load(xr + 128 * j); v[q][2 * j + 1] = __builtin_nontemporal_load(xr + 128 * j + 1); } }
#pragma unroll
        for (int q = 0; q < 4; ++q) { float s = 0.f;
#pragma unroll
            for (int j = 0; j < 4; ++j) s += (v[q][j].x * v[q][j].x + v[q][j].y * v[q][j].y) + (v[q][j].z * v[q][j].z + v[q][j].w * v[q][j].w);
            s = wave_sum(s); if (lane == 0) ss0[m0 + q] = s;
            GAS v4u* o16 = (GAS v4u*)(XB + (size_t)(m0 + q) * D) + lane;
#pragma unroll
            for (int j = 0; j < 2; ++j) { v4u o; o.x = pk2(v[q][2 * j].x, v[q][2 * j].y); o.y = pk2(v[q][2 * j].z, v[q][2 * j].w); o.z = pk2(v[q][2 * j + 1].x, v[q][2 * j + 1].y); o.w = pk2(v[q][2 * j + 1].z, v[q][2 * j + 1].w); o16[64 * j] = o; } }
    }
    float* rc = (float*)(ws + WS_ROPE); float* rsn = rc + 2048 * 16;
    for (int e = gw * 64 + lane; e < 2048 * 16; e += NGW * 64) { const int pos = e >> 4, i = e & 15;
        const float inv = 1.0f / powf(10000.0f, (float)(2 * i) / 32.0f); const float ang = (float)pos * inv; rc[e] = cosf(ang); rsn[e] = sinf(ang); }
}

__global__ void __launch_bounds__(NWAVES * 64, 2) mk_fwd(Args args) {
    extern __shared__ __attribute__((aligned(16))) unsigned char lds[];
    Frame F;
    F.lds = (LAS unsigned char*)lds;
    F.MISC = (volatile LAS unsigned*)(F.lds + MISC_OFF);
    F.tid = threadIdx.x; F.lane = F.tid & 63; F.wave = __builtin_amdgcn_readfirstlane(F.tid >> 6);
    F.G = gridDim.x; { const int bx = blockIdx.x; F.vcu = (F.G % 8 == 0) ? (bx % 8) * (F.G / 8) + bx / 8 : bx; }
    unsigned char* ws = args.ws;
    F.ctl = (gu32*)(ws + WS_CTL);
    for (int u = F.tid; u < (LDS_BYTES - LDSCTL_OFF) / 4; u += NWAVES * 64) ((LAS unsigned*)(F.lds + LDSCTL_OFF))[u] = 0u;
    __syncthreads();
    XcdBarrier bar; bar.bar = (unsigned*)(F.ctl + CW_BAR); bar.x = 0; bar.st = nullptr;
    if (N_LAUNCHES != PER_PHASE) bar = xcd_barrier_post((unsigned*)(F.ctl + CW_BAR), F.MISC + 8);
#define GRID_BAR() do { if (N_LAUNCHES != PER_PHASE) xcd_barrier(bar); } while (0)
    const int lo = args.ph_lo, hi = args.ph_hi;
#define IN(k) (lo <= (k) && (k) < hi)
#define BOTH(k) (IN(k) && IN((k) + 1))

    bf16* XB = (bf16*)(ws + WS_XB); bf16* HID = (bf16*)(ws + WS_HID); bf16* Y = (bf16*)(ws + WS_Y);
    float* ss0 = (float*)(ws + WS_SS0); float* ss1 = (float*)(ws + WS_SS1); float* ss2 = (float*)(ws + WS_SS2);
    pg8::MixBufs MB;
    MB.HQKV = (bf16*)(ws + WS_HQKV); MB.KPE = (bf16*)(ws + WS_KPE); MB.SQ = (bf16*)(ws + WS_SQ); MB.SK = (bf16*)(ws + WS_SK); MB.SV = (bf16*)(ws + WS_SV);
    MB.QM = (bf16*)(ws + WS_QM); MB.KN = (bf16*)(ws + WS_KN); MB.VM = (bf16*)(ws + WS_VM);
    MB.ssq = (float*)(ws + WS_SSQ); MB.sskv = (float*)(ws + WS_SSKV); MB.ss1 = ss1;
    MB.g_kr = args.in[14]; MB.g_sq = args.in[15]; MB.g_sk = args.in[16]; MB.g_qn = args.in[11]; MB.g_qr = args.in[12]; MB.g_kn = args.in[13];
    MB.rcos = (const float*)(ws + WS_ROPE); MB.rsin = MB.rcos + 2048 * 16; MB.noatom = 0;

    if (IN(0)) { REPS(0) p0_prologue(F, args); if (BOTH(0)) GRID_BAR(); }
    if (IN(1)) { pg8::Gemm g{XB, (const bf16*)(ws + WS_W1GU), M, NGU, D}; pg8::StatOrder<pg8::StaticOrder> S; S.S.init(M, NGU, D, F.G, (int)blockIdx.x); S.ssA = ss0; S.ssB = ss0; S.pnB = 1 << 30; S.lds = F.lds;
        pg8::EpiSwiGLU E{HID, F.lds, FF};
        REPS(1) pg8::gemm_phase<pg8::EpiSwiGLU, pg8::StatOrder<pg8::StaticOrder>, MK_ALIGN_GU, true>(F.lds + RING_OFF, g, S, E);
        if (MK_DUP == 101) { pg8::EpiNull EN; pg8::gemm_phase<pg8::EpiNull, pg8::StaticOrder, true, true>(F.lds + RING_OFF, g, S.S, EN); }
        if (BOTH(1)) GRID_BAR(); }
    if (IN(2)) { pg8::Gemm g{HID, (const bf16*)(ws + WS_W1D), M, D, FF}; pg8::StaticOrder S; S.init(M, D, FF, F.G, (int)blockIdx.x);
        { pg8::EpiRes E{XB, XB, nullptr, ss1, 0.5f, F.lds + RING_OFF};
        pg8::gemm_phase<pg8::EpiRes, pg8::StaticOrder, true, true>(F.lds + RING_OFF, g, S, E); }
        if (MK_DUP == 2) { pg8::EpiRes E{XB, (bf16*)(ws + WS_Y), nullptr, nullptr, 0.f, F.lds + RING_OFF};
        pg8::gemm_phase<pg8::EpiRes, pg8::StaticOrder, true, true>(F.lds + RING_OFF, g, S, E); }
        if (BOTH(2)) GRID_BAR(); }
    if (IN(3)) { pg8::Gemm g{XB, (const bf16*)(ws + WS_WIN), M, NWIN, D}; pg8::StatOrder<pg8::StaticOrder> S; S.S.init(M, NWIN, D, F.G, (int)blockIdx.x); S.ssA = ss1; S.ssB = ss1; S.pnB = 1 << 30; S.lds = F.lds;
        REPS(3) { pg8::EpiWin E{MB, F.lds}; E.B.noatom = rep;
        pg8::gemm_phase<pg8::EpiWin, pg8::StatOrder<pg8::StaticOrder>, true, true>(F.lds + RING_OFF, g, S, E); }
        { const int nu3 = (M / 256) * (NWIN / 256), maxu = (nu3 + F.G - 1) / F.G, rem = nu3 - (maxu - 1) * F.G, nidle = F.G - rem;
          if (nidle == 0) convert_weights(F, args, 1, (int)blockIdx.x * NWAVES + F.wave, F.G * NWAVES);
          else if ((int)blockIdx.x >= rem) convert_weights(F, args, 1, ((int)blockIdx.x - rem) * NWAVES + F.wave, nidle * NWAVES); }
        if (BOTH(3)) GRID_BAR(); }
    if (IN(4)) { pg8::Gemm g{MB.HQKV, (const bf16*)(ws + WS_WUP), M, NUP, KUP}; pg8::StatOrder<pg8::UpOrder> S; S.S.S.init(M, NUP, KUP, F.G, (int)blockIdx.x); S.ssA = MB.ssq; S.ssB = MB.sskv; S.pnB = 3; S.lds = F.lds;
        pg8::EpiUp E{MB, F.lds};
        REPS(4) pg8::gemm_phase<pg8::EpiUp, pg8::StatOrder<pg8::UpOrder>, true, true>(F.lds + RING_OFF, g, S, E);
        const float* sink = args.in[17];
        const int upc = (1024 + F.G - 1) / F.G, au0 = F.vcu * upc, anu = au0 >= 1024 ? 0 : (1024 - au0 < upc ? 1024 - au0 : upc);
        REPS(40) { att::Bufs AB{MB.SQ, MB.SK, nullptr, MB.SV, Y}; if (anu > 0) att::att_phase<true>(au0, anu, AB, (char*)lds + RING_OFF, sink); }
        if (BOTH(4)) GRID_BAR(); }
    if (IN(5)) {
        const int upc = (1024 + F.G - 1) / F.G, au0 = F.vcu * upc, anu = au0 >= 1024 ? 0 : (1024 - au0 < upc ? 1024 - au0 : upc);
        REPS(5) { att::Bufs AB{MB.QM, MB.KN, MB.KPE, MB.VM, Y}; if (anu > 0) att::att_phase<false>(au0, anu, AB, (char*)lds + RING_OFF, nullptr); }
        if (BOTH(5)) GRID_BAR(); }
    if (IN(6)) { pg8::Gemm g{Y, (const bf16*)(ws + WS_WO), M, D, D}; pg8::StaticOrder S; S.init(M, D, D, F.G, (int)blockIdx.x);
        { pg8::EpiRes E{XB, XB, nullptr, ss2, 1.0f, F.lds + RING_OFF};
        pg8::gemm_phase<pg8::EpiRes, pg8::StaticOrder, true, true>(F.lds + RING_OFF, g, S, E); }
        if (MK_DUP == 6) { pg8::EpiRes E{XB, (bf16*)(ws + WS_HID), nullptr, nullptr, 0.f, F.lds + RING_OFF};
        pg8::gemm_phase<pg8::EpiRes, pg8::StaticOrder, true, true>(F.lds + RING_OFF, g, S, E); }
        if (BOTH(6)) GRID_BAR(); }
    if (IN(7)) { pg8::Gemm g{XB, (const bf16*)(ws + WS_W2GU), M, NGU, D}; pg8::StatOrder<pg8::StaticOrder> S; S.S.init(M, NGU, D, F.G, (int)blockIdx.x); S.ssA = ss2; S.ssB = ss2; S.pnB = 1 << 30; S.lds = F.lds;
        pg8::EpiSwiGLU E{HID, F.lds, FF};
        pg8::gemm_phase<pg8::EpiSwiGLU, pg8::StatOrder<pg8::StaticOrder>, MK_ALIGN_GU, true>(F.lds + RING_OFF, g, S, E);
        if (BOTH(7)) GRID_BAR(); }
    if (IN(8)) { pg8::Gemm g{HID, (const bf16*)(ws + WS_W2D), M, D, FF}; pg8::StaticOrder S; S.init(M, D, FF, F.G, (int)blockIdx.x);
        pg8::EpiRes E{XB, nullptr, args.out, nullptr, 0.5f, F.lds + RING_OFF};
        pg8::gemm_phase<pg8::EpiRes, pg8::StaticOrder, true, true>(F.lds + RING_OFF, g, S, E); }
#undef IN
#undef BOTH
#undef GRID_BAR
}

extern "C" void kernel_launch(void* const* d_in, const int* in_sizes, int n_in, void* d_out, int out_size, void* d_ws, size_t ws_size, hipStream_t stream) {
    static int grid = 0;
    if (grid == 0) {
        if (n_in != 23 || in_sizes[0] != M * D || out_size != M * D || ws_size < WS_END) { fprintf(stderr, "kernel_launch: unexpected shapes (n_in %d, in0 %d, out %d, ws %zu); nothing launched\n", n_in, n_in > 0 ? in_sizes[0] : -1, out_size, ws_size); grid = -1; return; }
        int dev = 0, cus = 0, per_cu = 0;
        if (hipGetDevice(&dev) != hipSuccess || hipDeviceGetAttribute(&cus, hipDeviceAttributeMultiprocessorCount, dev) != hipSuccess) { grid = -1; return; }
        if (hipFuncSetAttribute((const void*)mk_fwd, hipFuncAttributeMaxDynamicSharedMemorySize, LDS_BYTES) != hipSuccess) { fprintf(stderr, "kernel_launch: hipFuncSetAttribute failed\n"); grid = -1; return; }
        if (hipOccupancyMaxActiveBlocksPerMultiprocessor(&per_cu, (const void*)mk_fwd, NWAVES * 64, LDS_BYTES) != hipSuccess || per_cu < 1) { fprintf(stderr, "kernel_launch: occupancy query reports %d workgroups per CU\n", per_cu); }
        (void)hipGetLastError();
        grid = cus;
    }
    if (grid < 0) return;
    if (hipMemsetAsync((char*)d_ws + WS_CTL, 0, CTL_ZERO_BYTES, stream) != hipSuccess) return;
    Args a{};
    for (int i = 0; i < 23; ++i) a.in[i] = (const float*)d_in[i];
    a.out = (float*)d_out; a.ws = (unsigned char*)d_ws;
    if (N_LAUNCHES == PER_PHASE) {
        for (int li = 0; li < PER_PHASE; ++li) { a.ph_lo = li; a.ph_hi = li + 1; a.li = li; hipLaunchKernelGGL(mk_fwd, dim3(grid), dim3(NWAVES * 64), LDS_BYTES, stream, a); }
    } else {
        a.ph_lo = 0; a.ph_hi = PER_PHASE; a.li = 0;
        hipLaunchKernelGGL(mk_fwd, dim3(grid), dim3(NWAVES * 64), LDS_BYTES, stream, a);
    }
}
```

```cpp
#include <hip/hip_runtime.h>
#include <hip/hip_bf16.h>
#include <cstdio>
#include <cstdint>
#include <cmath>

#ifndef MK_N_LAUNCHES
#define MK_N_LAUNCHES 1
#endif
#ifndef MK_ALIGN_GU
#define MK_ALIGN_GU true
#endif
#ifndef MK_TST
#define MK_TST 1
#endif
#ifndef MK_TST_GU
#define MK_TST_GU 0
#endif
#ifndef MK_TLD
#define MK_TLD 1
#endif
#ifndef MK_DUP
#define MK_DUP -1
#endif
#define REPS(k) for (int rep = 0; rep < ((MK_DUP == (k)) ? 2 : 1); ++rep)

namespace pg8 {
#define PG8_LAS __attribute__((address_space(3)))
typedef unsigned short bf16_t;
typedef short bf16x8 __attribute__((ext_vector_type(8)));
typedef float f32x4 __attribute__((ext_vector_type(4)));
typedef unsigned u32x4 __attribute__((ext_vector_type(4)));
constexpr int BM = 256, BK = 64, HALF = 128, HTB = HALF * BK * 2  , STAGE_BYTES = 8 * HTB, NXCD = 8, WGM = 8;
constexpr float RMS_EPS = 1e-6f;
constexpr float LOG2E = 1.4426950408889634f;

__host__ __device__ __forceinline__ int lds_byte(int r, int c) { const int st = (r >> 4) * 2 + (c >> 5), rr = r & 15, cc = c & 31, ob = rr * 64 + cc * 2; return st * 1024 + (ob ^ (((ob >> 9) & 1) << 5)); }
__host__ __device__ __forceinline__ void stage_rc(int b, int& R, int& C) { const int st = b / 1024, sb = b % 1024, swz = sb ^ (((sb >> 9) & 1) << 5); R = (st >> 1) * 16 + swz / 64; C = (st & 1) * 32 + (swz % 64) / 2; }
__host__ __device__ __forceinline__ int perm32(int rho) { const int n = rho >> 4, i = rho & 15; return 8 * (i >> 2) + 4 * n + (i & 3); }

struct Unit { int pm, pn, koff, nt, par; };
struct Gemm { const bf16_t* A; const bf16_t* Bt; int M, N, K; };

struct StaticOrder {
    int nM, nN, nwg, G, c, nt;
    __host__ __device__ void init(int M, int N, int K, int G_, int c_) { nM = M / BM; nN = N / BM; nwg = nM * nN; G = G_; c = c_; nt = K / BK; }
    __host__ __device__ bool next(int i, Unit& u) const {
        const long L = (long)i * G + c; if (L >= nwg) return false;
        int wgid = (int)L; { const int q = nwg / NXCD, r = nwg % NXCD, xcd = wgid % NXCD, off = wgid / NXCD; wgid = (xcd < r ? xcd * (q + 1) : r * (q + 1) + (xcd - r) * q) + off; }
        const int nig = WGM * nN, gid = wgid / nig, fm = gid * WGM, gsz = (nM - fm) < WGM ? (nM - fm) : WGM;
        u.pm = fm + ((wgid % nig) % gsz); u.pn = (wgid % nig) / gsz; u.koff = 0; u.nt = nt; u.par = i & 1; return true;
    }
    __device__ __forceinline__ void a_ready(const Unit&) const {}
    __device__ __forceinline__ void done(const Unit&) const {}
};

struct UpOrder {
    StaticOrder S;
    __device__ bool next(int i, Unit& u) const { if (!S.next(i, u)) return false; if (u.pn < 3) { u.koff = 0; u.nt = 4; } else { u.koff = 256 * 2; u.nt = 2; } return true; }
    __device__ __forceinline__ void a_ready(const Unit&) const {}
    __device__ __forceinline__ void done(const Unit&) const {}
};

constexpr int SSB_OFF = STAGE_BYTES + 2048;
template <class Base> struct StatOrder {
    Base S; const float* ssA; const float* ssB; int pnB;
    PG8_LAS unsigned char* lds;
    __device__ bool next(int i, Unit& u) const { return S.next(i, u); }
    __device__ __forceinline__ void a_ready(const Unit& u) const {
        const int tid = threadIdx.x, w = __builtin_amdgcn_readfirstlane(tid >> 6);
        if (w < 4) { const float* src = (u.pn < pnB ? ssA : ssB) + u.pm * BM + tid;
            __builtin_amdgcn_global_load_lds((const unsigned*)src, (PG8_LAS unsigned*)(lds + SSB_OFF + u.par * 1024 + w * 256), 4, 0, 0); }
    }
    __device__ __forceinline__ void done(const Unit&) const {}
};
__device__ __forceinline__ void lds_rows8(float (&v)[2][4], PG8_LAS unsigned char* lds, const Unit& u, int wr, int fr) {
    const PG8_LAS float* p = (const PG8_LAS float*)(lds + SSB_OFF + u.par * 1024) + wr * 64 + fr;
#pragma unroll
    for (int ai = 0; ai < 2; ++ai)
#pragma unroll
        for (int m = 0; m < 4; ++m) v[ai][m] = p[ai * HALF + m * 16];
}

__device__ __forceinline__ unsigned cvt_pk_bf16(float lo, float hi) { unsigned r; asm volatile("v_cvt_pk_bf16_f32 %0, %1, %2" : "=v"(r) : "v"(lo), "v"(hi)); return r; }
__device__ __forceinline__ u32x4 pack8(const f32x4 a, const f32x4 b) { u32x4 w; w.x = cvt_pk_bf16(a[0], a[1]); w.y = cvt_pk_bf16(a[2], a[3]); w.z = cvt_pk_bf16(b[0], b[1]); w.w = cvt_pk_bf16(b[2], b[3]); return w; }
struct TSt { PG8_LAS unsigned char* a0; PG8_LAS unsigned char* a1; int wofs, rofs, wofs32, rofs32, drow, c3, fr, fq, lane; };
__device__ __forceinline__ TSt tst_init(PG8_LAS unsigned char* lds, int wr, int wc, int fr, int fq) {
    const int wid = wr * 4 + wc, lane = fr + 16 * fq; TSt t;
    t.a0 = lds + 3 * HTB + wid * 1024; t.a1 = t.a0 + 8192;
    t.wofs = fr * 64 + ((fq ^ ((fr >> 1) & 3)) * 16); t.rofs = (lane >> 2) * 64 + (((lane & 3) ^ ((lane >> 3) & 3)) * 16);
    t.wofs32 = (fr & 7) * 128 + (((2 * fq) ^ (fr & 7)) * 16); t.rofs32 = (lane >> 3) * 128 + (((lane & 7) ^ (lane >> 3)) * 16);
    t.drow = (lane >> 2) - fr; t.c3 = 8 * (lane & 3); t.fr = fr; t.fq = fq; t.lane = lane; return t; }
__device__ __forceinline__ void tst16(const TSt& t, int sel, const u32x4 w, bf16_t* P, int pitch) {
#if MK_TST
    PG8_LAS unsigned char* a = sel ? t.a1 : t.a0;
    *(PG8_LAS u32x4*)(a + t.wofs) = w;
    const u32x4 v = *(const PG8_LAS u32x4*)(a + t.rofs);
    *(u32x4*)(P + (long)t.drow * pitch + t.c3) = v;
#else
    *(u32x4*)(P + 8 * t.fq) = w;
#endif
}
__device__ __forceinline__ u32x4 tld16(const TSt& t, int sel, const u32x4 w) {
    PG8_LAS unsigned char* a = sel ? t.a1 : t.a0;
    *(PG8_LAS u32x4*)(a + t.rofs) = w;
    return *(const PG8_LAS u32x4*)(a + t.wofs);
}
__device__ __forceinline__ void tst32f(const TSt& t, const f32x4 v0, const f32x4 v1, float* P, int pitch) {
#if MK_TST
    PG8_LAS unsigned char* aw = ((t.fr & 8) ? t.a1 : t.a0) + t.wofs32;
    *(PG8_LAS f32x4*)(aw) = v0; *(PG8_LAS f32x4*)(((t.fr & 8) ? t.a1 : t.a0) + (t.wofs32 ^ 16)) = v1;
    const f32x4 r0 = *(const PG8_LAS f32x4*)(t.a0 + t.rofs32), r1 = *(const PG8_LAS f32x4*)(t.a1 + t.rofs32);
    float* Q = P + (long)((t.lane >> 3) - t.fr) * pitch + 4 * (t.lane & 7);
    *(f32x4*)Q = r0; *(f32x4*)(Q + (long)8 * pitch) = r1;
#else
    *(f32x4*)(P + 8 * t.fq) = v0; *(f32x4*)(P + 8 * t.fq + 4) = v1;
#endif
}
__device__ __forceinline__ float dot4(const f32x4 a) { return (a[0] * a[0] + a[1] * a[1]) + (a[2] * a[2] + a[3] * a[3]); }
__device__ __forceinline__ float hsum4(f32x4 t) { asm("" : "+v"(t)); return (t[0] + t[1]) + (t[2] + t[3]); }
__device__ __forceinline__ float sumsq8(const f32x4 a, const f32x4 b) { f32x4 t = a * a; t = b * b + t; return hsum4(t); }
__device__ __forceinline__ float sumsq16(const f32x4 a, const f32x4 b, const f32x4 c, const f32x4 d) { f32x4 t = a * a; t = b * b + t; t = c * c + t; t = d * d + t; return hsum4(t); }
__device__ __forceinline__ float sum_fq(float s) {
    const auto a = __builtin_amdgcn_permlane32_swap(__float_as_uint(s), __float_as_uint(s), false, false); s = __uint_as_float(a[0]) + __uint_as_float(a[1]);
    const auto b = __builtin_amdgcn_permlane16_swap(__float_as_uint(s), __float_as_uint(s), false, false); return __uint_as_float(b[0]) + __uint_as_float(b[1]); }
__device__ __forceinline__ float silu_f(float g) { return g * __builtin_amdgcn_rcpf(1.0f + __builtin_amdgcn_exp2f(-LOG2E * g)); }
__device__ __forceinline__ float rs_of(float ss, float inv_n) { return __builtin_amdgcn_rsqf(ss * inv_n + RMS_EPS); }

__device__ __forceinline__ void load_rows8(float (&v)[2][4], const float* p, int row0) {
#pragma unroll
    for (int ai = 0; ai < 2; ++ai)
#pragma unroll
        for (int m = 0; m < 4; ++m) v[ai][m] = p[row0 + ai * HALF + m * 16];
    asm volatile("" : "+v"(v[0][0]), "+v"(v[0][1]), "+v"(v[0][2]), "+v"(v[0][3]), "+v"(v[1][0]), "+v"(v[1][1]), "+v"(v[1][2]), "+v"(v[1][3]));
}

struct EpiSwiGLU {
    static constexpr bool PERM = true, AFTER_DRAIN = false;
    bf16_t* H; PG8_LAS unsigned char* lds; int ldh;
    __device__ __forceinline__ void operator()(const f32x4 (&acc)[2][2][4][2], const Unit& u, int wr, int wc, int fr, int fq) const {
        asm volatile("" : "+v"(fr), "+v"(fq));
        const int row0 = u.pm * BM + wr * 64 + fr, colb = u.pn * HALF + wc * 32;
        const TSt T = tst_init(lds, wr, wc, fr, fq);
        float sv[2][4]; lds_rows8(sv, lds, u, wr, fr);
#pragma unroll
        for (int ai = 0; ai < 2; ++ai)
#pragma unroll
            for (int m = 0; m < 4; ++m) {
                const int row = row0 + ai * HALF + m * 16;
                const float ir2 = sv[ai][m] * (1.0f / 1024.0f) + RMS_EPS, c = -LOG2E * __builtin_amdgcn_rsqf(ir2);
                f32x4 h[2];
#pragma unroll
                for (int n = 0; n < 2; ++n) { const f32x4 g = acc[ai][0][m][n], up = acc[ai][1][m][n]; const f32x4 t = g * c; f32x4 e, w;
#pragma unroll
                    for (int i = 0; i < 4; ++i) e[i] = __builtin_amdgcn_exp2f(t[i]);
                    const f32x4 d = e * ir2 + ir2;
#pragma unroll
                    for (int i = 0; i < 4; ++i) w[i] = __builtin_amdgcn_rcpf(d[i]);
                    h[n] = (g * up) * w; }
                if (MK_TST_GU) tst16(T, m & 1, pack8(h[0], h[1]), H + (size_t)row * ldh + colb, ldh);
                else *(u32x4*)(H + (size_t)row * ldh + colb + 8 * fq) = pack8(h[0], h[1]);
            }
    }
};

__device__ __forceinline__ void unpack8(const u32x4 w, f32x4& a, f32x4& b) {
    a[0] = __uint_as_float(w.x << 16); a[1] = __uint_as_float(w.x & 0xffff0000u); a[2] = __uint_as_float(w.y << 16); a[3] = __uint_as_float(w.y & 0xffff0000u);
    b[0] = __uint_as_float(w.z << 16); b[1] = __uint_as_float(w.z & 0xffff0000u); b[2] = __uint_as_float(w.w << 16); b[3] = __uint_as_float(w.w & 0xffff0000u); }
struct EpiRes {
    static constexpr bool PERM = true, AFTER_DRAIN = false;
    const bf16_t* base; bf16_t* xb; float* outf; float* ss; float alpha; PG8_LAS unsigned char* lds;
    __device__ __forceinline__ void operator()(const f32x4 (&acc)[2][2][4][2], const Unit& u, int wr, int wc, int fr, int fq) const {
        asm volatile("" : "+v"(fr), "+v"(fq));
        const int row0 = u.pm * BM + wr * 64 + fr, col0 = u.pn * BM + wc * 32 + 8 * fq, colb = u.pn * BM + wc * 32;
        const TSt T = tst_init(lds, wr, wc, fr, fq);
        u32x4 b[2][4][2];
#pragma unroll
        for (int ai = 0; ai < 2; ++ai)
#pragma unroll
            for (int m = 0; m < 4; ++m) { const size_t off = (size_t)(row0 + ai * HALF + m * 16) * 1024 + col0;
#pragma unroll
                for (int bj = 0; bj < 2; ++bj) b[ai][m][bj] = MK_TLD ? *(const u32x4*)(base + (size_t)(row0 + ai * HALF + m * 16 + T.drow) * 1024 + colb + bj * HALF + T.c3)
                                                                     : *(const u32x4*)(base + off + bj * HALF); }
#pragma unroll
        for (int ai = 0; ai < 2; ++ai)
#pragma unroll
            for (int m = 0; m < 4; ++m) asm volatile("" : "+v"(b[ai][m][0]), "+v"(b[ai][m][1]));
#pragma unroll
        for (int ai = 0; ai < 2; ++ai) {
#pragma unroll
            for (int m = 0; m < 4; ++m) { const int row = row0 + ai * HALF + m * 16; const size_t off = (size_t)row * 1024 + col0; float s = 0.f;
#pragma unroll
                for (int bj = 0; bj < 2; ++bj) { f32x4 b0, b1; unpack8(MK_TLD ? tld16(T, bj, b[ai][m][bj]) : b[ai][m][bj], b0, b1);
                    const f32x4 v0 = b0 + acc[ai][bj][m][0] * alpha, v1 = b1 + acc[ai][bj][m][1] * alpha;
                    if (outf) tst32f(T, v0, v1, outf + (size_t)row * 1024 + colb + bj * HALF, 1024);
                    if (xb) tst16(T, bj, pack8(v0, v1), xb + (size_t)row * 1024 + colb + bj * HALF, 1024);
                    s += sumsq8(v0, v1); }
                if (ss) { s = sum_fq(s); if (fq == 0) unsafeAtomicAdd(ss + row, s); } }
        }
    }
};

struct EpiNull {
    static constexpr bool PERM = true, AFTER_DRAIN = false;
    __device__ __forceinline__ void operator()(const f32x4 (&acc)[2][2][4][2], const Unit&, int, int, int, int) const {
#pragma unroll
        for (int ai = 0; ai < 2; ++ai)
#pragma unroll
            for (int bj = 0; bj < 2; ++bj)
#pragma unroll
                for (int m = 0; m < 4; ++m) asm volatile("" :: "v"(acc[ai][bj][m][0]), "v"(acc[ai][bj][m][1]));
    }
};

struct MixBufs {
    bf16_t *HQKV, *KPE, *SQ, *SK, *SV, *QM, *KN, *VM;
    float *ssq, *sskv; const float *ss1;
    const float *g_kr, *g_sq, *g_sk, *g_qn, *g_qr, *g_kn;
    const float *rcos, *rsin;
    int noatom;
};
constexpr float C_SWA = 0.125f * LOG2E;
constexpr float C_MLA = 0.10206207261596577f * LOG2E;

__device__ __forceinline__ void head64_norm_store(const f32x4 v00, const f32x4 v01, const f32x4 v10, const f32x4 v11, float r, const f32x4 (&g)[2][2], float post, bf16_t* dst, int pitch, const TSt& T) {
    const float s = sum_fq(sumsq16(v00, v01, v10, v11));
    const float rr = rs_of(s * (r * r), 1.0f / 64.0f) * (r * post);
    tst16(T, 0, pack8(v00 * rr * g[0][0], v01 * rr * g[0][1]), dst, pitch);
    tst16(T, 1, pack8(v10 * rr * g[1][0], v11 * rr * g[1][1]), dst + 32, pitch);
}
__device__ __forceinline__ void rope32_norm_store_cs(f32x4 x1, f32x4 x2, float r, const f32x4 g1, const f32x4 g2, const f32x4 cs, const f32x4 sn, float post, bf16_t* dst, int pitch, const TSt& T) {
    const float s = sum_fq(sumsq8(x1, x2));
    const float rr = rs_of(s * (r * r), 1.0f / 32.0f) * (r * post);
    x1 = x1 * rr * g1; x2 = x2 * rr * g2;
    const f32x4 o1 = x1 * cs - x2 * sn, o2 = x2 * cs + x1 * sn;
    tst16(T, 0, pack8(o1, o2), dst, pitch);
}
__device__ __forceinline__ void load_rope4(f32x4 (&cs)[4], f32x4 (&sn)[4], const float* rcos, const float* rsin, int rowa, int fq) {
#pragma unroll
    for (int m = 0; m < 4; ++m) { const int pos = (rowa + m * 16) & 2047; cs[m] = *(const f32x4*)(rcos + pos * 16 + 4 * fq); sn[m] = *(const f32x4*)(rsin + pos * 16 + 4 * fq); }
#pragma unroll
    for (int m = 0; m < 4; ++m) asm volatile("" : "+v"(cs[m]), "+v"(sn[m]));
}
__device__ __forceinline__ void load_g64(f32x4 (&g)[2][2], const float* gp, int fq) {
#pragma unroll
    for (int bj = 0; bj < 2; ++bj)
#pragma unroll
        for (int n = 0; n < 2; ++n) g[bj][n] = *(const f32x4*)(gp + 32 * bj + 8 * fq + 4 * n);
}

struct EpiWin {
    static constexpr bool PERM = true, AFTER_DRAIN = false;
    MixBufs B; PG8_LAS unsigned char* lds;
    __device__ __forceinline__ void operator()(const f32x4 (&acc)[2][2][4][2], const Unit& u, int wr, int wc, int fr, int fq) const {
        asm volatile("" : "+v"(fr), "+v"(fq));
        const int row0 = u.pm * BM + wr * 64 + fr; const int pn = u.pn;
        const TSt T = tst_init(lds, wr, wc, fr, fq);
        float sv[2][4]; lds_rows8(sv, lds, u, wr, fr);
        if (pn == 0) {
#pragma unroll
            for (int ai = 0; ai < 2; ++ai)
#pragma unroll
                for (int m = 0; m < 4; ++m) { const int row = row0 + ai * HALF + m * 16; const float r = rs_of(sv[ai][m], 1.0f / 1024.0f); float s = 0.f;
#pragma unroll
                    for (int bj = 0; bj < 2; ++bj) { const f32x4 v0 = acc[ai][bj][m][0] * r, v1 = acc[ai][bj][m][1] * r; s += sumsq8(v0, v1);
                        tst16(T, bj, pack8(v0, v1), B.HQKV + (size_t)row * 384 + bj * HALF + wc * 32, 384); }
                    s = sum_fq(s); if (fq == 0 && !B.noatom) unsafeAtomicAdd(B.ssq + row, s); }
        } else if (pn == 1) {
            const f32x4 g1 = *(const f32x4*)(B.g_kr + 4 * fq), g2 = *(const f32x4*)(B.g_kr + 16 + 4 * fq);
#pragma unroll
            for (int ai = 0; ai < 2; ++ai) {
                f32x4 cs[4], sn[4]; if (wc == 0) load_rope4(cs, sn, B.rcos, B.rsin, row0 + ai * HALF, fq);
#pragma unroll
                for (int m = 0; m < 4; ++m) { const int row = row0 + ai * HALF + m * 16; const float r = rs_of(sv[ai][m], 1.0f / 1024.0f);
                    const f32x4 v0 = acc[ai][0][m][0] * r, v1 = acc[ai][0][m][1] * r;
                    tst16(T, 0, pack8(v0, v1), B.HQKV + (size_t)row * 384 + 256 + wc * 32, 384);
                    const float s = sum_fq(sumsq8(v0, v1)); if (fq == 0 && !B.noatom) unsafeAtomicAdd(B.sskv + row, s);
                    if (wc == 0) rope32_norm_store_cs(acc[ai][1][m][0], acc[ai][1][m][1], r, g1, g2, cs[m], sn[m], 1.0f, B.KPE + (size_t)row * 32, 32, T); } }
        } else if (pn < 4) {
            f32x4 g[2][2]; load_g64(g, B.g_sq, fq); const int head = 4 * (pn - 2) + wc;
#pragma unroll
            for (int ai = 0; ai < 2; ++ai)
#pragma unroll
                for (int m = 0; m < 4; ++m) { const int row = row0 + ai * HALF + m * 16; const float r = rs_of(sv[ai][m], 1.0f / 1024.0f);
                    head64_norm_store(acc[ai][0][m][0], acc[ai][0][m][1], acc[ai][1][m][0], acc[ai][1][m][1], r, g, C_SWA, B.SQ + (size_t)row * 512 + head * 64, 512, T); }
        } else {
            if (wc < 2) { f32x4 g[2][2]; load_g64(g, B.g_sk, fq);
#pragma unroll
                for (int ai = 0; ai < 2; ++ai)
#pragma unroll
                    for (int m = 0; m < 4; ++m) { const int row = row0 + ai * HALF + m * 16; const float r = rs_of(sv[ai][m], 1.0f / 1024.0f);
                        head64_norm_store(acc[ai][0][m][0], acc[ai][0][m][1], acc[ai][1][m][0], acc[ai][1][m][1], r, g, 1.0f, B.SK + (size_t)row * 128 + wc * 64, 128, T); }
            } else {
#pragma unroll
                for (int ai = 0; ai < 2; ++ai)
#pragma unroll
                    for (int m = 0; m < 4; ++m) { const int row = row0 + ai * HALF + m * 16; const float r = rs_of(sv[ai][m], 1.0f / 1024.0f); bf16_t* dst = B.SV + (size_t)row * 128 + (wc - 2) * 64;
                        tst16(T, 0, pack8(acc[ai][0][m][0] * r, acc[ai][0][m][1] * r), dst, 128); tst16(T, 1, pack8(acc[ai][1][m][0] * r, acc[ai][1][m][1] * r), dst + 32, 128); }
            }
        }
    }
};

struct EpiUp {
    static constexpr bool PERM = true, AFTER_DRAIN = false;
    MixBufs B; PG8_LAS unsigned char* lds;
    __device__ __forceinline__ void operator()(const f32x4 (&acc)[2][2][4][2], const Unit& u, int wr, int wc, int fr, int fq) const {
        asm volatile("" : "+v"(fr), "+v"(fq));
        const int row0 = u.pm * BM + wr * 64 + fr; const int pn = u.pn;
        const TSt T = tst_init(lds, wr, wc, fr, fq);
        float sv[2][4]; lds_rows8(sv, lds, u, wr, fr);
        if (pn < 2) {
            f32x4 g[2][2]; load_g64(g, B.g_qn, fq); const int head = 4 * pn + wc;
#pragma unroll
            for (int ai = 0; ai < 2; ++ai)
#pragma unroll
                for (int m = 0; m < 4; ++m) { const int row = row0 + ai * HALF + m * 16; const float r = rs_of(sv[ai][m], 1.0f / 256.0f);
                    head64_norm_store(acc[ai][0][m][0], acc[ai][0][m][1], acc[ai][1][m][0], acc[ai][1][m][1], r, g, C_MLA, B.QM + (size_t)row * 768 + head * 96, 768, T); }
        } else if (pn == 2) {
            const f32x4 g1 = *(const f32x4*)(B.g_qr + 4 * fq), g2 = *(const f32x4*)(B.g_qr + 16 + 4 * fq);
#pragma unroll
            for (int ai = 0; ai < 2; ++ai) {
                f32x4 cs[4], sn[4]; load_rope4(cs, sn, B.rcos, B.rsin, row0 + ai * HALF, fq);
#pragma unroll
                for (int m = 0; m < 4; ++m) { const int row = row0 + ai * HALF + m * 16; const float r = rs_of(sv[ai][m], 1.0f / 256.0f);
#pragma unroll
                    for (int bj = 0; bj < 2; ++bj) rope32_norm_store_cs(acc[ai][bj][m][0], acc[ai][bj][m][1], r, g1, g2, cs[m], sn[m], C_MLA, B.QM + (size_t)row * 768 + (4 * bj + wc) * 96 + 64, 768, T); } }
        } else if (pn < 5) {
            f32x4 g[2][2]; load_g64(g, B.g_kn, fq); const int head = 4 * (pn - 3) + wc;
#pragma unroll
            for (int ai = 0; ai < 2; ++ai)
#pragma unroll
                for (int m = 0; m < 4; ++m) { const int row = row0 + ai * HALF + m * 16; const float r = rs_of(sv[ai][m], 1.0f / 128.0f);
                    head64_norm_store(acc[ai][0][m][0], acc[ai][0][m][1], acc[ai][1][m][0], acc[ai][1][m][1], r, g, 1.0f, B.KN + (size_t)row * 512 + head * 64, 512, T); }
        } else {
            const int head = 4 * (pn - 5) + wc;
#pragma unroll
            for (int ai = 0; ai < 2; ++ai)
#pragma unroll
                for (int m = 0; m < 4; ++m) { const int row = row0 + ai * HALF + m * 16; const float r = rs_of(sv[ai][m], 1.0f / 128.0f); bf16_t* dst = B.VM + (size_t)row * 512 + head * 64;
                    tst16(T, 0, pack8(acc[ai][0][m][0] * r, acc[ai][0][m][1] * r), dst, 512); tst16(T, 1, pack8(acc[ai][1][m][0] * r, acc[ai][1][m][1] * r), dst + 32, 512); }
        }
    }
};

template <class Epi, class Sched, bool ALIGN_EPI = false, bool SP2 = false>
__device__ __forceinline__ void gemm_phase(PG8_LAS unsigned char* lds, const Gemm g, const Sched& S, const Epi& E) {
    const int tid = threadIdx.x, wid = __builtin_amdgcn_readfirstlane(tid >> 6), lane = tid & 63, wr = wid >> 2, wc = wid & 3, fr = lane & 15, fq = lane >> 4;
    const int K = g.K;
    unsigned voffA[2], voffB[2];
#pragma unroll
    for (int i = 0; i < 2; ++i) { int R, C; stage_rc(tid * 16 + i * 8192, R, C); const int Rb = Epi::PERM ? ((R & ~31) + perm32(R & 31)) : R;
        voffA[i] = (unsigned)(R * K + C) * 2u; voffB[i] = (unsigned)(Rb * K + C) * 2u; }
    const size_t kstep = (size_t)(BK * 2);
    const size_t hstep = (size_t)HALF * K * 2;
    const size_t tstep = 2 * hstep;
    const unsigned ldsw = (unsigned)wid * 1024u;
    const int aoff = lds_byte(wr * 64 + fr, fq * 8), boff = lds_byte(wc * 32 + fr, fq * 8);
#define PG8_SA(b, h) (((b) * 2 + (h)) * HTB)
#define PG8_SB(b, h) ((4 + (b) * 2 + (h)) * HTB)
#define PG8_STAGE(bufoff, gbase, voff) do { _Pragma("unroll") for (int _i = 0; _i < 2; ++_i) \
        __builtin_amdgcn_global_load_lds((const unsigned*)((const char*)(gbase) + (voff)[_i]), (PG8_LAS unsigned*)(lds + (bufoff) + ldsw + _i * 8192), 16, 0, 0); } while (0)
#define PG8_LDA(dst, b, h) do { _Pragma("unroll") for (int m = 0; m < 4; ++m) _Pragma("unroll") for (int k = 0; k < 2; ++k) dst[m][k] = *(const PG8_LAS bf16x8*)(lds + PG8_SA(b, h) + aoff + m * 2048 + k * 1024); } while (0)
#define PG8_LDB(dst, b, h) do { _Pragma("unroll") for (int n = 0; n < 2; ++n) _Pragma("unroll") for (int k = 0; k < 2; ++k) dst[n][k] = *(const PG8_LAS bf16x8*)(lds + PG8_SB(b, h) + boff + n * 2048 + k * 1024); } while (0)
#define PG8_MMA(ai, bj, At, Bt) do { __builtin_amdgcn_s_setprio(1); _Pragma("unroll") for (int m = 0; m < 4; ++m) _Pragma("unroll") for (int n = 0; n < 2; ++n) _Pragma("unroll") for (int k = 0; k < 2; ++k) \
        acc[ai][bj][m][n] = __builtin_amdgcn_mfma_f32_16x16x32_bf16(Bt[n][k], At[m][k], acc[ai][bj][m][n], 0, 0, 0); __builtin_amdgcn_s_setprio(0); } while (0)
#define PG8_WAIT_V(n) asm volatile("s_waitcnt vmcnt(" #n ")" ::: "memory")
#define PG8_WAIT_L(n) asm volatile("s_waitcnt lgkmcnt(" #n ")" ::: "memory")
#define PG8_BAR __builtin_amdgcn_s_barrier()
#define PG8_SCHED __builtin_amdgcn_sched_barrier(0)
    Unit cur, nxt; int ui = 0;
    if (!S.next(0, cur)) return;
    f32x4 acc[2][2][4][2];
#pragma unroll
    for (int a = 0; a < 2; ++a)
#pragma unroll
        for (int b = 0; b < 2; ++b)
#pragma unroll
            for (int m = 0; m < 4; ++m)
#pragma unroll
                for (int n = 0; n < 2; ++n) acc[a][b][m][n] = (f32x4){0.f, 0.f, 0.f, 0.f};
    bf16x8 At[4][2], B0[2][2], B1[2][2];
    const char* cA = (const char*)g.A + (size_t)cur.pm * tstep + cur.koff; const char* cB = (const char*)g.Bt + (size_t)cur.pn * tstep + cur.koff;
    S.a_ready(cur);
    if constexpr (SP2) {
        PG8_STAGE(PG8_SB(0, 0), cB, voffB); PG8_STAGE(PG8_SB(0, 1), cB + hstep, voffB); PG8_STAGE(PG8_SA(0, 0), cA, voffA); PG8_STAGE(PG8_SA(0, 1), cA + hstep, voffA);
        if (wr == 1) PG8_BAR;
        PG8_WAIT_V(2); PG8_BAR;
        PG8_STAGE(PG8_SB(1, 0), cB + kstep, voffB); PG8_STAGE(PG8_SA(1, 0), cA + kstep, voffA); PG8_STAGE(PG8_SB(1, 1), cB + hstep + kstep, voffB);
        PG8_WAIT_V(6); PG8_BAR;
    } else {
        PG8_STAGE(PG8_SB(0, 0), cB, voffB); PG8_STAGE(PG8_SA(0, 0), cA, voffA); PG8_STAGE(PG8_SB(0, 1), cB + hstep, voffB); PG8_STAGE(PG8_SA(0, 1), cA + hstep, voffA);
        if (wr == 1) PG8_BAR;
        PG8_WAIT_V(4); PG8_BAR;
        PG8_STAGE(PG8_SB(1, 0), cB + kstep, voffB); PG8_STAGE(PG8_SA(1, 0), cA + kstep, voffA); PG8_STAGE(PG8_SB(1, 1), cB + hstep + kstep, voffB);
        PG8_WAIT_V(6); PG8_BAR;
    }
    for (;;) {
        const bool has_next = S.next(ui + 1, nxt);
        const char* nA = has_next ? (const char*)g.A + (size_t)nxt.pm * tstep + nxt.koff : cA; const char* nB = has_next ? (const char*)g.Bt + (size_t)nxt.pn * tstep + nxt.koff : cB;
        const int nt = cur.nt;
#pragma unroll 1
        for (int t = 0; t < nt; t += 2) {
            const bool last = (t == nt - 2);
            const char* a1 = cA + (size_t)(t + 1) * kstep;
            const char* a2 = last ? nA : cA + (size_t)(t + 2) * kstep; const char* b2 = last ? nB : cB + (size_t)(t + 2) * kstep;
            const char* a3 = a2 + kstep; const char* b3 = b2 + kstep;
            if (last && has_next) S.a_ready(nxt);
            if constexpr (SP2) {
            PG8_LDB(B0, 0, 0); PG8_LDB(B1, 0, 1); PG8_SCHED; PG8_LDA(At, 0, 0); PG8_STAGE(PG8_SA(1, 1), a1 + hstep, voffA);
            PG8_WAIT_V(8); PG8_WAIT_L(0); PG8_BAR; PG8_MMA(0, 0, At, B0); PG8_MMA(0, 1, At, B1); PG8_BAR; PG8_SCHED;
            PG8_LDA(At, 0, 1); PG8_STAGE(PG8_SB(0, 0), b2, voffB); PG8_STAGE(PG8_SB(0, 1), b2 + hstep, voffB); PG8_STAGE(PG8_SA(0, 0), a2, voffA);
            PG8_WAIT_V(8); PG8_WAIT_L(0); PG8_BAR; PG8_MMA(1, 0, At, B0); PG8_MMA(1, 1, At, B1); PG8_BAR; PG8_SCHED;
            PG8_LDB(B0, 1, 0); PG8_LDB(B1, 1, 1); PG8_SCHED; PG8_LDA(At, 1, 0); PG8_STAGE(PG8_SA(0, 1), a2 + hstep, voffA);
            PG8_WAIT_V(8); PG8_WAIT_L(0); PG8_BAR; PG8_MMA(0, 0, At, B0); PG8_MMA(0, 1, At, B1); PG8_BAR; PG8_SCHED;
            PG8_LDA(At, 1, 1); PG8_STAGE(PG8_SB(1, 0), b3, voffB); PG8_STAGE(PG8_SB(1, 1), b3 + hstep, voffB); PG8_STAGE(PG8_SA(1, 0), a3, voffA);
            PG8_WAIT_V(8); PG8_WAIT_L(0); PG8_BAR; PG8_MMA(1, 0, At, B0); PG8_MMA(1, 1, At, B1); PG8_BAR; PG8_SCHED;
            } else {
            PG8_LDB(B0, 0, 0); PG8_SCHED; PG8_LDA(At, 0, 0); PG8_STAGE(PG8_SA(1, 1), a1 + hstep, voffA);
            PG8_WAIT_L(8); PG8_BAR; PG8_WAIT_L(0); PG8_MMA(0, 0, At, B0); PG8_BAR; PG8_SCHED;
            PG8_LDB(B1, 0, 1); PG8_STAGE(PG8_SB(0, 0), b2, voffB);
            PG8_BAR; PG8_WAIT_L(0); PG8_MMA(0, 1, At, B1); PG8_BAR;
            PG8_LDA(At, 0, 1); PG8_STAGE(PG8_SA(0, 0), a2, voffA);
            PG8_BAR; PG8_WAIT_L(0); PG8_MMA(1, 0, At, B0); PG8_BAR; PG8_SCHED;
            PG8_STAGE(PG8_SB(0, 1), b2 + hstep, voffB);
            PG8_WAIT_V(6); PG8_BAR; PG8_MMA(1, 1, At, B1); PG8_BAR;
            PG8_LDB(B0, 1, 0); PG8_SCHED; PG8_LDA(At, 1, 0); PG8_STAGE(PG8_SA(0, 1), a2 + hstep, voffA);
            PG8_WAIT_L(8); PG8_BAR; PG8_WAIT_L(0); PG8_MMA(0, 0, At, B0); PG8_BAR; PG8_SCHED;
            PG8_LDB(B1, 1, 1); PG8_STAGE(PG8_SB(1, 0), b3, voffB);
            PG8_BAR; PG8_WAIT_L(0); PG8_MMA(0, 1, At, B1); PG8_BAR;
            PG8_LDA(At, 1, 1); PG8_STAGE(PG8_SA(1, 0), a3, voffA);
            PG8_BAR; PG8_WAIT_L(0); PG8_MMA(1, 0, At, B0); PG8_BAR; PG8_SCHED;
            PG8_STAGE(PG8_SB(1, 1), b3 + hstep, voffB);
            PG8_WAIT_V(6); PG8_BAR; PG8_MMA(1, 1, At, B1); PG8_BAR;
            }
        }
        if constexpr (ALIGN_EPI) { if (wr == 0) PG8_BAR; }
        if constexpr (!Epi::AFTER_DRAIN) { E(acc, cur, wr, wc, fr, fq); S.done(cur); }
        if (!has_next) break;
#pragma unroll
        for (int a = 0; a < 2; ++a)
#pragma unroll
            for (int b = 0; b < 2; ++b)
#pragma unroll
                for (int m = 0; m < 4; ++m)
#pragma unroll
                    for (int n = 0; n < 2; ++n) acc[a][b][m][n] = (f32x4){0.f, 0.f, 0.f, 0.f};
        cur = nxt; cA = nA; cB = nB; ++ui;
        if constexpr (ALIGN_EPI) { if (wr == 1) PG8_BAR; }
    }
    PG8_WAIT_V(0);
    if constexpr (!ALIGN_EPI) { if (wr == 0) PG8_BAR; }
    PG8_BAR;
#undef PG8_SA
#undef PG8_SB
#undef PG8_STAGE
#undef PG8_LDA
#undef PG8_LDB
#undef PG8_MMA
#undef PG8_WAIT_V
#undef PG8_WAIT_L
#undef PG8_BAR
#undef PG8_SCHED
}
}

namespace att {
using bf16x8 = __attribute__((ext_vector_type(8))) short;
using s16x4 = __attribute__((ext_vector_type(4))) short;
using f32x16 = __attribute__((ext_vector_type(16))) float;
using u32x4 = __attribute__((ext_vector_type(4))) unsigned;
typedef unsigned short bf16_t;
typedef __attribute__((address_space(3))) const char* lds_cptr;
typedef __attribute__((address_space(3))) char* lds_ptr;
typedef __attribute__((address_space(3))) float* lds_fptr;
typedef short v4i16_t __attribute__((ext_vector_type(4)));
constexpr int SEQ = 2048, QB = 256, KVBLK = 64;
constexpr int KBUF = 12288, VBUF = 8192, LDS_K = 0, LDS_V = 2 * KBUF, LDS_WS = LDS_V + 2 * VBUF, LDS_OST = LDS_WS + 8 * 256, LDS_BYTES = LDS_OST + 8 * 4096;
constexpr float THR = 8.0f, LOG2E_A = 1.4426950408889634f;
__device__ __forceinline__ int crow(int r, int hi) { return (r & 3) + 8 * (r >> 2) + 4 * hi; }
__device__ __forceinline__ void glds16(const void* gsrc, unsigned lds_dst) { unsigned keep;
    asm volatile("s_mov_b32 %0, m0\n\ts_mov_b32 m0, %2\n\ts_nop 0\n\tglobal_load_lds_dwordx4 %1, off\n\ts_mov_b32 m0, %0" : "=&s"(keep) : "v"(gsrc), "s"(lds_dst) : "memory"); }
typedef float f32x2_t __attribute__((ext_vector_type(2))); typedef __bf16 bf16x2_t __attribute__((ext_vector_type(2)));
__device__ __forceinline__ unsigned cvtpk(float lo, float hi) { f32x2_t v = {lo, hi}; bf16x2_t b = __builtin_convertvector(v, bf16x2_t); return __builtin_bit_cast(unsigned, b); }
__device__ __forceinline__ s16x4 vtr(lds_cptr p) { return __builtin_bit_cast(s16x4, __builtin_amdgcn_ds_read_tr16_b64_v4i16((__attribute__((address_space(3))) v4i16_t*)p)); }
__device__ __forceinline__ float fadd_s(float a, float b) { float r = a + b; asm("" : "+v"(r)); return r; }
#define ATT_MX3(a, b, c) __builtin_fmaxf(__builtin_fmaxf((a), (b)), (c))
__device__ __forceinline__ float rowmax(const f32x16& p0, const f32x16& p1) {
    float a = ATT_MX3(p0[0], p0[1], p1[0]), b = ATT_MX3(p0[2], p0[3], p1[1]); a = ATT_MX3(a, p1[2], p1[3]);
#pragma unroll
    for (int r = 4; r < 16; r += 4) { a = ATT_MX3(a, p0[r], p0[r + 1]); b = ATT_MX3(b, p0[r + 2], p0[r + 3]); a = ATT_MX3(a, p1[r], p1[r + 1]); b = ATT_MX3(b, p1[r + 2], p1[r + 3]); }
    float m = __builtin_fmaxf(a, b); auto rr = __builtin_amdgcn_permlane32_swap(__float_as_uint(m), __float_as_uint(m), false, false);
    return __builtin_fmaxf(__uint_as_float(rr[0]), __uint_as_float(rr[1])); }

__device__ __forceinline__ void glds16s(const void* sbase_, unsigned voff, unsigned lds_dst) { unsigned keep;
    const unsigned long long a_ = (unsigned long long)sbase_; const unsigned long long sbase = ((unsigned long long)(unsigned)__builtin_amdgcn_readfirstlane((int)(a_ >> 32)) << 32) | (unsigned)__builtin_amdgcn_readfirstlane((int)a_);
    asm volatile("s_nop 4\n\ts_mov_b32 %0, m0\n\ts_mov_b32 m0, %3\n\ts_nop 0\n\tglobal_load_lds_dwordx4 %1, %2\n\ts_mov_b32 m0, %0" : "=&s"(keep) : "v"(voff), "s"(sbase), "s"(lds_dst) : "memory"); }

struct Bufs { const bf16_t* Q; const bf16_t* K; const bf16_t* KPE; const bf16_t* V; bf16_t* O; };
struct USel { long rowbase; int q0, t0, t1, qcol, kcol, ocol, head0; };

template <bool SWA>
__device__ __forceinline__ void att_phase(const int u0, const int NU, const Bufs B, char* shm, const float* sink) {
    constexpr int ND0 = SWA ? 4 : 6, QP = SWA ? 512 : 768, KP = SWA ? 128 : 512, VP = KP;
    int tid = threadIdx.x; asm volatile("" : "+v"(tid));
    const int lane = tid & 63, r32 = lane & 31, hi = lane >> 5; const int wid = __builtin_amdgcn_readfirstlane(tid >> 6);
    const int hsub = SWA ? (wid & 3) : 0, wrow = SWA ? (wid >> 2) * 32 : wid * 32;
    const unsigned lds0 = (unsigned)(uintptr_t)shm;
    const lds_cptr shm3 = (lds_cptr)shm;
    lds_fptr wsf = (lds_fptr)((lds_ptr)shm + LDS_WS) + wid * 64;
    const unsigned koff = (unsigned)((lane * KP + wid * 8) * 2), peoff = (unsigned)((lane * 32 + wid * 8) * 2);
    const unsigned voff = (unsigned)(((16 * (wid & 3) + (lane >> 2)) * VP + (wid >> 2) * 32 + (lane & 3) * 8) * 2);
    const unsigned kdst = lds0 + LDS_K + wid * 1024, pedst = lds0 + LDS_K + (8 + wid) * 1024, vdst = lds0 + LDS_V + wid * 1024;
    const lds_cptr kp0 = shm3 + LDS_K + hi * 1024 + r32 * 16;
    const lds_cptr vp0 = shm3 + LDS_V + ((lane >> 4) & 1) * 32 + (lane & 3) * 8 + (4 * hi + ((lane & 15) >> 2)) * 64;
    auto decode = [&](int u) { USel s;
        if (SWA) { const int rb = u & 31, kvh = (u >> 5) & 1, b = u >> 6; s.rowbase = (long)b * SEQ; s.q0 = rb * 64; s.t0 = rb - 2 < 0 ? 0 : rb - 2; s.t1 = rb + 3 > SEQ / KVBLK ? SEQ / KVBLK : rb + 3;
                   s.qcol = kvh * 256; s.kcol = kvh * 64; s.ocol = 512 + kvh * 256; s.head0 = kvh * 4; }
        else { const int qb = u & 7, h = (u >> 3) & 7, b = u >> 6; s.rowbase = (long)b * SEQ; s.q0 = qb * QB; s.t0 = 0; s.t1 = SEQ / KVBLK; s.qcol = h * 96; s.kcol = h * 64; s.ocol = h * 64; s.head0 = h; }
        return s; };
#define ATT_DMA(s, t, slot) do { glds16s(B.K + ((s).rowbase + (long)(t) * KVBLK) * KP + (s).kcol, koff, (unsigned)__builtin_amdgcn_readfirstlane(kdst + (slot) * KBUF)); \
        if (!SWA && wid < 4) glds16s(B.KPE + ((s).rowbase + (long)(t) * KVBLK) * 32, peoff, (unsigned)__builtin_amdgcn_readfirstlane(pedst + (slot) * KBUF)); \
        glds16s(B.V + ((s).rowbase + (long)(t) * KVBLK) * VP + (s).kcol, voff, (unsigned)__builtin_amdgcn_readfirstlane(vdst + (slot) * VBUF)); } while (0)
#define ATT_WAIT_BAR() asm volatile("s_waitcnt vmcnt(0) lgkmcnt(0)\n\ts_barrier" ::: "memory")
#define ATT_LOADQ(s) do { const bf16_t* Qw_ = B.Q + ((s).rowbase + (s).q0 + wrow + r32) * QP + (s).qcol + hsub * 64 + hi * 8; \
        _Pragma("unroll") for (int d0 = 0; d0 < ND0; ++d0) qr[d0] = *reinterpret_cast<const bf16x8*>(Qw_ + d0 * 16); } while (0)
    USel cur = decode(u0);
    int slot = 0;
    bf16x8 qr[ND0];
    ATT_DMA(cur, cur.t0, 0);
    ATT_LOADQ(cur);
#pragma unroll 1
    for (int iu = 0; iu < NU; ++iu) {
        const bool has_next = iu + 1 < NU;
        const USel nxt = decode(has_next ? u0 + iu + 1 : u0 + iu);
        const int w0 = cur.q0 + wrow;
        const float slope2 = SWA ? LOG2E_A * __builtin_amdgcn_exp2f(-(float)(cur.head0 + hsub + 1)) : 0.f;
        const float sink2 = SWA ? sink[cur.head0 + hsub] * LOG2E_A : 0.f;
        float mhat = SWA ? sink2 : 0.f, l_reg = SWA ? (hi == 0 ? 1.f : 0.f) : 0.f;
        f32x16 o[2]; o[0] = f32x16{}; o[1] = f32x16{};
        f32x16 negm;
#pragma unroll
        for (int r = 0; r < 16; ++r) negm[r] = -mhat;
        asm volatile("" : "+v"(negm));
        ATT_WAIT_BAR();
        for (int t = cur.t0; t < cur.t1; ++t) {
            const bool active = !SWA || ((t * 64 + 63 >= w0 - 128) && (t * 64 <= w0 + 31 + 128));
            bf16x8 kf[2 * ND0];
            if (active) { const lds_cptr kp = kp0 + slot * KBUF;
#pragma unroll
                for (int d0 = 0; d0 < ND0; ++d0) { kf[2 * d0] = *(const __attribute__((address_space(3))) bf16x8*)(kp + d0 * 2048); kf[2 * d0 + 1] = *(const __attribute__((address_space(3))) bf16x8*)(kp + d0 * 2048 + 512); } }
            __builtin_amdgcn_sched_barrier(0);
            if (t + 1 < cur.t1) ATT_DMA(cur, t + 1, slot ^ 1); else if (has_next) ATT_DMA(nxt, nxt.t0, slot ^ 1);
            if (active) {
                f32x16 p0, p1;
                __builtin_amdgcn_sched_barrier(0);
#pragma unroll
                for (int d0 = 0; d0 < ND0; ++d0) {
                    p0 = __builtin_amdgcn_mfma_f32_32x32x16_bf16(kf[2 * d0], qr[d0], d0 == 0 ? negm : p0, 0, 0, 0);
                    p1 = __builtin_amdgcn_mfma_f32_32x32x16_bf16(kf[2 * d0 + 1], qr[d0], d0 == 0 ? negm : p1, 0, 0, 0);
                }
                __builtin_amdgcn_sched_barrier(0);
                const lds_cptr vp = vp0 + slot * VBUF;
                s16x4 vlo[8], vhi[8];
#pragma unroll
                for (int i = 0; i < 8; ++i) { vlo[i] = vtr(vp + (i >> 2) * 4096 + (i & 3) * 1024); vhi[i] = vtr(vp + (i >> 2) * 4096 + (i & 3) * 1024 + 512); }
                __builtin_amdgcn_sched_barrier(0);
                if (SWA) {
                    const float qf = (float)(w0 + r32 - t * 64 - 4 * hi);
#pragma unroll
                    for (int r = 0; r < 16; ++r) { const float d0 = (float)((r & 3) + 8 * (r >> 2)) - qf, d1 = d0 + 32.0f;
                        p0[r] = (__builtin_fabsf(d0) <= 128.0f) ? __builtin_fmaf(-slope2, __builtin_fabsf(d0), p0[r]) : -INFINITY;
                        p1[r] = (__builtin_fabsf(d1) <= 128.0f) ? __builtin_fmaf(-slope2, __builtin_fabsf(d1), p1[r]) : -INFINITY; }
                }
                const float rm = rowmax(p0, p1);
                const bool first = !SWA && (t == cur.t0);
                if (first || __any(rm > THR)) {
                    const float dl = first ? rm : __builtin_fmaxf(rm, 0.f);
                    mhat += dl;
#pragma unroll
                    for (int r = 0; r < 16; ++r) { p0[r] -= dl; p1[r] -= dl; }
#pragma unroll
                    for (int r = 0; r < 16; ++r) negm[r] = -mhat;
                    asm volatile("" : "+v"(negm));
                    const float f = __builtin_amdgcn_exp2f(-dl); l_reg *= f;
                    if (!first) {
                        if (hi == 0) wsf[r32] = f;
#pragma unroll
                        for (int r = 0; r < 16; ++r) { const float fr_ = wsf[crow(r, hi)]; o[0][r] *= fr_; o[1][r] *= fr_; }
                    }
                }
#pragma unroll
                for (int r = 0; r < 16; ++r) { p0[r] = __builtin_amdgcn_exp2f(p0[r]); p1[r] = __builtin_amdgcn_exp2f(p1[r]); }
                float sa = fadd_s(p0[0], p0[1]), sb = fadd_s(p1[0], p1[1]);
#pragma unroll
                for (int r = 2; r < 16; ++r) { sa = fadd_s(sa, p0[r]); sb = fadd_s(sb, p1[r]); }
                l_reg += fadd_s(sa, sb);
                u32x4 pw[4];
#pragma unroll
                for (int j = 0; j < 4; ++j) { pw[0][j] = cvtpk(p0[2 * j], p0[2 * j + 1]); pw[1][j] = cvtpk(p0[8 + 2 * j], p0[9 + 2 * j]); pw[2][j] = cvtpk(p1[2 * j], p1[2 * j + 1]); pw[3][j] = cvtpk(p1[8 + 2 * j], p1[9 + 2 * j]); }
#pragma unroll
                for (int d0 = 0; d0 < 2; ++d0)
#pragma unroll
                    for (int ks = 0; ks < 4; ++ks) { const s16x4 lo = vlo[d0 * 4 + ks], hh = vhi[d0 * 4 + ks];
                        const bf16x8 vf = (bf16x8){lo[0], lo[1], lo[2], lo[3], hh[0], hh[1], hh[2], hh[3]};
                        o[d0] = __builtin_amdgcn_mfma_f32_32x32x16_bf16(__builtin_bit_cast(bf16x8, pw[ks]), vf, o[d0], 0, 0, 0); }
            }
            if (t + 1 < cur.t1) ATT_WAIT_BAR();
            slot ^= 1;
        }
        if (has_next) ATT_LOADQ(nxt);
        { auto rr = __builtin_amdgcn_permlane32_swap(__float_as_uint(l_reg), __float_as_uint(l_reg), false, false); l_reg = __uint_as_float(rr[0]) + __uint_as_float(rr[1]); }
        if (hi == 0) wsf[32 + r32] = l_reg;
        float rli[16];
#pragma unroll
        for (int r = 0; r < 16; ++r) rli[r] = __builtin_amdgcn_rcpf(wsf[32 + crow(r, hi)]);
        {
            __attribute__((address_space(3))) bf16_t* stg = (__attribute__((address_space(3))) bf16_t*)((lds_ptr)shm + LDS_OST) + wid * 2048;
#pragma unroll
            for (int r = 0; r < 16; ++r) { const int orow = crow(r, hi);
#pragma unroll
                for (int d0 = 0; d0 < 2; ++d0) { const float v = o[d0][r] * rli[r]; stg[orow * 64 + d0 * 32 + r32] = (bf16_t)(cvtpk(v, v) & 0xffffu); } }
            bf16_t* Ow = B.O + (cur.rowbase + w0) * 1024 + cur.ocol + hsub * 64;
#pragma unroll
            for (int i = 0; i < 4; ++i) { const int row = i * 8 + (lane >> 3), ch = lane & 7; const u32x4 v = *(const __attribute__((address_space(3))) u32x4*)(stg + row * 64 + ch * 8); *(u32x4*)(Ow + (long)row * 1024 + ch * 8) = v; }
        }
        cur = nxt;
    }
    ATT_WAIT_BAR();
#undef ATT_DMA
#undef ATT_WAIT_BAR
#undef ATT_LOADQ
}
}

constexpr int NWAVES = 8;
constexpr int N_LAUNCHES = MK_N_LAUNCHES;
constexpr int PER_PHASE = 9;
constexpr int BATCH = 16, SEQ = 2048, D = 1024, FF = 2816, M = BATCH * SEQ;
constexpr int NGU = 2 * FF  , NWIN = 1280, NUP = 1792, KUP = 384;

constexpr size_t MiB = 1u << 20;
constexpr size_t WS_CTL = 0, CTL_ZERO_BYTES = 1 * MiB;
constexpr size_t WS_SS1 = 256 * 1024, WS_SS2 = 384 * 1024, WS_SSQ = 512 * 1024, WS_SSKV = 640 * 1024, WS_SS0 = 768 * 1024;
constexpr size_t WS_ROPE = 1 * MiB;
constexpr size_t WS_W1GU = 2 * MiB, WS_W1D = 13 * MiB, WS_W2GU = 19 * MiB, WS_W2D = 30 * MiB, WS_WIN = 36 * MiB, WS_WUP = 39 * MiB, WS_WO = 41 * MiB;
constexpr size_t WS_XB = 48 * MiB;
constexpr size_t WS_HID = 112 * MiB;
constexpr size_t WS_HQKV = 112 * MiB, WS_KPE = 136 * MiB, WS_SQ = 138 * MiB, WS_SK = 170 * MiB, WS_SV = 178 * MiB, WS_QM = 186 * MiB, WS_KN = 234 * MiB, WS_VM = 266 * MiB;
constexpr size_t WS_Y = 298 * MiB, WS_END = 362 * MiB;
static_assert(WS_HID + (size_t)M * FF * 2 <= WS_Y && WS_VM + (size_t)M * 512 * 2 <= WS_Y && WS_Y + (size_t)M * D * 2 <= WS_END, "d_ws map");
static_assert(WS_W1GU + (size_t)NGU * D * 2 <= WS_W1D && WS_W1D + (size_t)D * FF * 2 <= WS_W2GU && WS_W2GU + (size_t)NGU * D * 2 <= WS_W2D && WS_W2D + (size_t)D * FF * 2 <= WS_WIN &&
              WS_WIN + (size_t)NWIN * D * 2 <= WS_WUP && WS_WUP + (size_t)NUP * KUP * 2 <= WS_WO && WS_WO + (size_t)D * D * 2 <= WS_XB, "weight map");
constexpr int CW_BAR = 4096;

constexpr int RING_OFF = 0, RING_BYTES = 131072;
constexpr int LDSCTL_OFF = RING_BYTES, MISC_OFF = LDSCTL_OFF + 320;
constexpr int LDS_BYTES = 147456;
static_assert(MISC_OFF + 128 <= LDS_BYTES && att::LDS_BYTES <= RING_BYTES, "LDS map");

#define GAS __attribute__((address_space(1)))
#define LAS __attribute__((address_space(3)))
typedef unsigned short bf16;
typedef unsigned v4u __attribute__((ext_vector_type(4)));
typedef float f32x4 __attribute__((ext_vector_type(4)));
typedef GAS unsigned gu32;
#define RLX_AGENT __ATOMIC_RELAXED, __HIP_MEMORY_SCOPE_AGENT
#define LDS_WAIT() asm volatile("s_waitcnt lgkmcnt(0)" ::: "memory")
#define VM_WAIT() asm volatile("s_waitcnt vmcnt(0)" ::: "memory")
__device__ __forceinline__ unsigned f2bf(float f) { unsigned u = __builtin_bit_cast(unsigned, f); return (u + 0x7fffu + ((u >> 16) & 1u)) >> 16; }
__device__ __forceinline__ unsigned pk2(float lo, float hi) { return f2bf(lo) | (f2bf(hi) << 16); }

#define XB_TMO      128
#define XB_XCNT(j)  (256  + 64 * (j))
#define XB_XSUB(j)  (1280 + 64 * (j))
#define XB_XGEN(j)  (2304 + 64 * (j))
#define XB_TOP      3328
#define XB_TOPGEN   3392
#define XCD_BAR_WORDS 3456
#define XB_SPIN_CAP (1u << 18)
__device__ __forceinline__ unsigned xb_ld(unsigned* p)              { return __hip_atomic_load(p, __ATOMIC_RELAXED, __HIP_MEMORY_SCOPE_AGENT); }
__device__ __forceinline__ unsigned xb_add(unsigned* p, unsigned v) { return __hip_atomic_fetch_add(p, v, __ATOMIC_RELAXED, __HIP_MEMORY_SCOPE_AGENT); }
__device__ __forceinline__ unsigned xb_xcc_id() { return (unsigned)__builtin_amdgcn_s_getreg((3 << 11) | 20) & 0xFu; }
#define XB_SPIN(cond, bar) do { unsigned _sp = 0; while (cond) { __builtin_amdgcn_s_sleep(1); \
    if ((++_sp & 255u) == 0u) { if (xb_ld(&(bar)[XB_TMO])) break; if (_sp > XB_SPIN_CAP) { atomicAdd(&(bar)[XB_TMO], 1u); break; } } } } while (0)
struct XcdBarrier { unsigned* bar; unsigned x; volatile LAS unsigned* st; };
__device__ __forceinline__ XcdBarrier xcd_barrier_post(unsigned* bar, volatile LAS unsigned* st) {
    XcdBarrier b; b.bar = bar; b.x = xb_xcc_id(); b.st = st;
    if (threadIdx.x == 0) (void)xb_add(&bar[XB_XCNT(b.x)], 1u);
    return b;
}
__device__ __forceinline__ void xcd_barrier_complete(unsigned* bar, unsigned x, unsigned& nloc, unsigned& nx) {
    const unsigned G = gridDim.x * gridDim.y * gridDim.z;
    unsigned sum, cnt, mine, sp = 0u;
    for (;;) {
        sum = 0u; cnt = 0u; mine = 0u;
#pragma unroll
        for (unsigned j = 0; j < 16; ++j) { const unsigned c = xb_ld(&bar[XB_XCNT(j)]); sum += c; cnt += (c > 0u) ? 1u : 0u; mine = (j == x) ? c : mine; }
        if (sum == G) break;
        __builtin_amdgcn_s_sleep(1);
        if ((++sp & 255u) == 0u) { if (xb_ld(&bar[XB_TMO])) break; if (sp > XB_SPIN_CAP) { atomicAdd(&bar[XB_TMO], 1u); break; } }
    }
    nloc = mine > 0u ? mine : 1u; nx = cnt > 0u ? cnt : 1u;
}
__device__ __forceinline__ void xcd_barrier(const XcdBarrier& b) {
    asm volatile("s_waitcnt vmcnt(0)" ::: "memory");
    __syncthreads();
    if (threadIdx.x == 0) {
        unsigned* bar = b.bar;
        __builtin_amdgcn_s_waitcnt(0);
        unsigned nloc = b.st[0], nx = b.st[1];
        if (nloc == 0u) { xcd_barrier_complete(bar, b.x, nloc, nx); b.st[0] = nloc; b.st[1] = nx; }
        const unsigned old = xb_add(&bar[XB_XSUB(b.x)], 1u);
        const unsigned gen = old / nloc;
        if (old + 1u == (gen + 1u) * nloc) {
            __builtin_amdgcn_fence(__ATOMIC_RELEASE, "agent");
            asm volatile("s_waitcnt vmcnt(0)" ::: "memory");
            const unsigned og = xb_add(&bar[XB_TOP], 1u);
            const unsigned tg = og / nx;
            if (og + 1u == (tg + 1u) * nx) xb_add(&bar[XB_TOPGEN], 1u);
            else XB_SPIN(xb_ld(&bar[XB_TOPGEN]) == tg, bar);
            __builtin_amdgcn_fence(__ATOMIC_ACQUIRE, "agent");
            xb_add(&bar[XB_XGEN(b.x)], 1u);
            asm volatile("s_waitcnt vmcnt(0)" ::: "memory");
        } else {
            XB_SPIN(xb_ld(&bar[XB_XGEN(b.x)]) == gen, bar);
            __builtin_amdgcn_fence(__ATOMIC_ACQUIRE, "agent");
            asm volatile("s_waitcnt vmcnt(0)" ::: "memory");
        }
    }
    __syncthreads();
}

__host__ __device__ __forceinline__ int rope_logical(int jj) { return 16 * ((jj >> 2) & 1) + 4 * (jj >> 3) + (jj & 3); }
__host__ __device__ __forceinline__ int win_src(int p) {
    const int pn = p >> 8, j = p & 255, bj = j >> 7, wc = (j >> 5) & 3, jj = j & 31;
    if (pn == 0) return j;
    if (pn == 1) { if (j < 128) return 256 + j; if (j < 160) return 384 + rope_logical(jj); return -1; }
    if (pn < 4) return 416 + (4 * (pn - 2) + wc) * 64 + 32 * bj + jj;
    return (wc < 2 ? 928 + wc * 64 : 1056 + (wc - 2) * 64) + 32 * bj + jj;
}
__host__ __device__ __forceinline__ int up_src(int p, bool& is_kv) {
    const int pn = p >> 8, j = p & 255, bj = j >> 7, wc = (j >> 5) & 3, jj = j & 31;
    if (pn < 2) { is_kv = false; return (4 * pn + wc) * 96 + 32 * bj + jj; }
    if (pn == 2) { is_kv = false; return (4 * bj + wc) * 96 + 64 + rope_logical(jj); }
    is_kv = true;
    if (pn < 5) return (4 * (pn - 3) + wc) * 128 + 32 * bj + jj;
    return (4 * (pn - 5) + wc) * 128 + 64 + 32 * bj + jj;
}

struct Frame {
    LAS unsigned char* lds;
    volatile LAS unsigned* MISC;
    gu32* ctl;
    int tid, lane, wave;
    int vcu, G;
};
struct Args { const float* in[23]; float* out; unsigned char* ws; int ph_lo, ph_hi, li, pad; };

__device__ __forceinline__ float wave_sum(float v) {
#pragma unroll
    for (int o = 1; o < 64; o <<= 1) v += __shfl_xor(v, o);
    return v;
}
__device__ __forceinline__ void p0_item(const float* W, int ldw, int ks0, const float* g, int col, bf16* dst, int Kp, LAS float* scr, int lane) {
    const bool z = (W == nullptr) || (col < 0);
    float wv[32];
#pragma unroll
    for (int i = 0; i < 32; ++i) { const int kk = 2 * i + (lane >> 5); wv[i] = z ? 0.f : W[(size_t)(ks0 + kk) * ldw + col]; }
#pragma unroll
    for (int i = 0; i < 32; ++i) { const int kk = 2 * i + (lane >> 5); float v = wv[i]; if (!z && g) v *= g[ks0 + kk]; scr[kk * 33 + (lane & 31)] = v; }
    LDS_WAIT(); asm volatile("" ::: "memory");
    const int c = lane & 7;
#pragma unroll
    for (int j = 0; j < 4; ++j) { const int n = (lane >> 3) + 8 * j; const LAS float* s = scr + (8 * c) * 33 + n;
        v4u o; o.x = pk2(s[0 * 33], s[1 * 33]); o.y = pk2(s[2 * 33], s[3 * 33]); o.z = pk2(s[4 * 33], s[5 * 33]); o.w = pk2(s[6 * 33], s[7 * 33]);
        *(GAS v4u*)(dst + (size_t)n * Kp + 8 * c) = o; }
    LDS_WAIT(); asm volatile("" ::: "memory");
}

__device__ __forceinline__ void convert_weights(Frame& F, const Args& a, int set, int worker, int nworkers) {
    LAS float* scr = (LAS float*)(F.lds + RING_OFF + F.wave * 16384);
    const int lane = F.lane; unsigned char* ws = a.ws;
    constexpr int I_GU = 16 * 176, I_D = 44 * 32, I_WIN = 16 * 40, I_UP = 6 * 56, I_WO = 16 * 32;
    const int nitems = set == 0 ? I_GU + I_D + I_WIN + I_UP : I_GU + I_D + I_WO;
    for (int it = worker; it < nitems; it += nworkers) {
        int r = it; const int f = set;
        if (r < I_GU) { const int kb = r / 176, nb = r % 176, p = nb * 32 + (lane & 31);
            const float* W = ((p >> 7) & 1) ? a.in[f ? 21 : 3] : a.in[f ? 20 : 2]; const int col = 128 * (p >> 8) + (p & 127);
            p0_item(W, FF, kb * 64, a.in[f ? 19 : 1], col, (bf16*)(ws + (f ? WS_W2GU : WS_W1GU)) + (size_t)(nb * 32) * D + kb * 64, D, scr, lane); continue; }
        r -= I_GU;
        if (r < I_D) { const int kb = r / 32, nb = r % 32;
            p0_item(a.in[f ? 22 : 4], D, kb * 64, nullptr, nb * 32 + (lane & 31), (bf16*)(ws + (f ? WS_W2D : WS_W1D)) + (size_t)(nb * 32) * FF + kb * 64, FF, scr, lane); continue; }
        r -= I_D;
        if (set == 1) { const int kb = r / 32, nb = r % 32;
            p0_item(a.in[18], D, kb * 64, nullptr, nb * 32 + (lane & 31), (bf16*)(ws + WS_WO) + (size_t)(nb * 32) * D + kb * 64, D, scr, lane); continue; }
        if (r < I_WIN) { const int kb = r / 40, nb = r % 40;
            p0_item(a.in[6], 1184, kb * 64, a.in[5], win_src(nb * 32 + (lane & 31)), (bf16*)(ws + WS_WIN) + (size_t)(nb * 32) * D + kb * 64, D, scr, lane); continue; }
        r -= I_WIN;
        { const int kb = r / 56, nb = r % 56; bool kv; const int col = up_src(nb * 32 + (lane & 31), kv);
            const bool live = kv ? (kb >= 4) : (kb < 4);
            p0_item(live ? (kv ? a.in[10] : a.in[8]) : nullptr, kv ? 1024 : 768, kv ? (kb - 4) * 64 : kb * 64, kv ? a.in[9] : a.in[7], col, (bf16*)(ws + WS_WUP) + (size_t)(nb * 32) * KUP + kb * 64, KUP, scr, lane); }
    }
}

__device__ __forceinline__ void p0_prologue(Frame& F, const Args& a) {
    const int gw = F.vcu * NWAVES + F.wave, NGW = F.G * NWAVES, lane = F.lane;
    unsigned char* ws = a.ws;
    convert_weights(F, a, 0, gw, NGW);
    const float* x = a.in[0]; bf16* XB = (bf16*)(ws + WS_XB); float* ss0 = (float*)(ws + WS_SS0);
    for (int m0 = gw * 4; m0 < M; m0 += NGW * 4) {
        f32x4 v[4][4];
#pragma unroll
        for (int q = 0; q < 4; ++q) { const GAS f32x4* xr = (const GAS f32x4*)(x + (size_t)(m0 + q) * D) + 2 * lane;
#pragma unroll
            for (int j = 0; j < 2; ++j) { v[q][2 * j] = __builtin_nontemporal_load(xr + 128 * j); v[q][2 * j + 1] = __builtin_nontemporal_load(xr + 128 * j + 1); } }
#pragma unroll
        for (int q = 0; q < 4; ++q) { float s = 0.f;
#pragma unroll
            for (int j = 0; j < 4; ++j) s += (v[q][j].x * v[q][j].x + v[q][j].y * v[q][j].y) + (v[q][j].z * v[q][j].z + v[q][j].w * v[q][j].w);
            s = wave_sum(s); if (lane == 0) ss0[m0 + q] = s;
            GAS v4u* o16 = (GAS v4u*)(XB + (size_t)(m0 + q) * D) + lane;
#pragma unroll
            for (int j = 0; j < 2; ++j) { v4u o; o.x = pk2(v[q][2 * j].x, v[q][2 * j].y); o.y = pk2(v[q][2 * j].z, v[q][2 * j].w); o.z = pk2(v[q][2 * j + 1].x, v[q][2 * j + 1].y); o.w = pk2(v[q][2 * j + 1].z, v[q][2 * j + 1].w); o16[64 * j] = o; } }
    }
    float* rc = (float*)(ws + WS_ROPE); float* rsn = rc + 2048 * 16;
    for (int e = gw * 64 + lane; e < 2048 * 16; e += NGW * 64) { const int pos = e >> 4, i = e & 15;
        const float inv = 1.0f / powf(10000.0f, (float)(2 * i) / 32.0f); const float ang = (float)pos * inv; rc[e] = cosf(ang); rsn[e] = sinf(ang); }
}

__global__ void __launch_bounds__(NWAVES * 64, 2) mk_fwd(Args args) {
    extern __shared__ __attribute__((aligned(16))) unsigned char lds[];
    Frame F;
    F.lds = (LAS unsigned char*)lds;
    F.MISC = (volatile LAS unsigned*)(F.lds + MISC_OFF);
    F.tid = threadIdx.x; F.lane = F.tid & 63; F.wave = __builtin_amdgcn_readfirstlane(F.tid >> 6);
    F.G = gridDim.x; { const int bx = blockIdx.x; F.vcu = (F.G % 8 == 0) ? (bx % 8) * (F.G / 8) + bx / 8 : bx; }
    unsigned char* ws = args.ws;
    F.ctl = (gu32*)(ws + WS_CTL);
    for (int u = F.tid; u < (LDS_BYTES - LDSCTL_OFF) / 4; u += NWAVES * 64) ((LAS unsigned*)(F.lds + LDSCTL_OFF))[u] = 0u;
    __syncthreads();
    XcdBarrier bar; bar.bar = (unsigned*)(F.ctl + CW_BAR); bar.x = 0; bar.st = nullptr;
    if (N_LAUNCHES != PER_PHASE) bar = xcd_barrier_post((unsigned*)(F.ctl + CW_BAR), F.MISC + 8);
#define GRID_BAR() do { if (N_LAUNCHES != PER_PHASE) xcd_barrier(bar); } while (0)
    const int lo = args.ph_lo, hi = args.ph_hi;
#define IN(k) (lo <= (k) && (k) < hi)
#define BOTH(k) (IN(k) && IN((k) + 1))

    bf16* XB = (bf16*)(ws + WS_XB); bf16* HID = (bf16*)(ws + WS_HID); bf16* Y = (bf16*)(ws + WS_Y);
    float* ss0 = (float*)(ws + WS_SS0); float* ss1 = (float*)(ws + WS_SS1); float* ss2 = (float*)(ws + WS_SS2);
    pg8::MixBufs MB;
    MB.HQKV = (bf16*)(ws + WS_HQKV); MB.KPE = (bf16*)(ws + WS_KPE); MB.SQ = (bf16*)(ws + WS_SQ); MB.SK = (bf16*)(ws + WS_SK); MB.SV = (bf16*)(ws + WS_SV);
    MB.QM = (bf16*)(ws + WS_QM); MB.KN = (bf16*)(ws + WS_KN); MB.VM = (bf16*)(ws + WS_VM);
    MB.ssq = (float*)(ws + WS_SSQ); MB.sskv = (float*)(ws + WS_SSKV); MB.ss1 = ss1;
    MB.g_kr = args.in[14]; MB.g_sq = args.in[15]; MB.g_sk = args.in[16]; MB.g_qn = args.in[11]; MB.g_qr = args.in[12]; MB.g_kn = args.in[13];
    MB.rcos = (const float*)(ws + WS_ROPE); MB.rsin = MB.rcos + 2048 * 16; MB.noatom = 0;

    if (IN(0)) { REPS(0) p0_prologue(F, args); if (BOTH(0)) GRID_BAR(); }
    if (IN(1)) { pg8::Gemm g{XB, (const bf16*)(ws + WS_W1GU), M, NGU, D}; pg8::StatOrder<pg8::StaticOrder> S; S.S.init(M, NGU, D, F.G, (int)blockIdx.x); S.ssA = ss0; S.ssB = ss0; S.pnB = 1 << 30; S.lds = F.lds;
        pg8::EpiSwiGLU E{HID, F.lds, FF};
        REPS(1) pg8::gemm_phase<pg8::EpiSwiGLU, pg8::StatOrder<pg8::StaticOrder>, MK_ALIGN_GU, true>(F.lds + RING_OFF, g, S, E);
        if (MK_DUP == 101) { pg8::EpiNull EN; pg8::gemm_phase<pg8::EpiNull, pg8::StaticOrder, true, true>(F.lds + RING_OFF, g, S.S, EN); }
        if (BOTH(1)) GRID_BAR(); }
    if (IN(2)) { pg8::Gemm g{HID, (const bf16*)(ws + WS_W1D), M, D, FF}; pg8::StaticOrder S; S.init(M, D, FF, F.G, (int)blockIdx.x);
        { pg8::EpiRes E{XB, XB, nullptr, ss1, 0.5f, F.lds + RING_OFF};
        pg8::gemm_phase<pg8::EpiRes, pg8::StaticOrder, true, true>(F.lds + RING_OFF, g, S, E); }
        if (MK_DUP == 2) { pg8::EpiRes E{XB, (bf16*)(ws + WS_Y), nullptr, nullptr, 0.f, F.lds + RING_OFF};
        pg8::gemm_phase<pg8::EpiRes, pg8::StaticOrder, true, true>(F.lds + RING_OFF, g, S, E); }
        if (BOTH(2)) GRID_BAR(); }
    if (IN(3)) { pg8::Gemm g{XB, (const bf16*)(ws + WS_WIN), M, NWIN, D}; pg8::StatOrder<pg8::StaticOrder> S; S.S.init(M, NWIN, D, F.G, (int)blockIdx.x); S.ssA = ss1; S.ssB = ss1; S.pnB = 1 << 30; S.lds = F.lds;
        REPS(3) { pg8::EpiWin E{MB, F.lds}; E.B.noatom = rep;
        pg8::gemm_phase<pg8::EpiWin, pg8::StatOrder<pg8::StaticOrder>, true, true>(F.lds + RING_OFF, g, S, E); }
        { const int nu3 = (M / 256) * (NWIN / 256), maxu = (nu3 + F.G - 1) / F.G, rem = nu3 - (maxu - 1) * F.G, nidle = F.G - rem;
          if (nidle == 0) convert_weights(F, args, 1, (int)blockIdx.x * NWAVES + F.wave, F.G * NWAVES);
          else if ((int)blockIdx.x >= rem) convert_weights(F, args, 1, ((int)blockIdx.x - rem) * NWAVES + F.wave, nidle * NWAVES); }
        if (BOTH(3)) GRID_BAR(); }
    if (IN(4)) { pg8::Gemm g{MB.HQKV, (const bf16*)(ws + WS_WUP), M, NUP, KUP}; pg8::StatOrder<pg8::UpOrder> S; S.S.S.init(M, NUP, KUP, F.G, (int)blockIdx.x); S.ssA = MB.ssq; S.ssB = MB.sskv; S.pnB = 3; S.lds = F.lds;
        pg8::EpiUp E{MB, F.lds};
        REPS(4) pg8::gemm_phase<pg8::EpiUp, pg8::StatOrder<pg8::UpOrder>, true, true>(F.lds + RING_OFF, g, S, E);
        const float* sink = args.in[17];
        const int upc = (1024 + F.G - 1) / F.G, au0 = F.vcu * upc, anu = au0 >= 1024 ? 0 : (1024 - au0 < upc ? 1024 - au0 : upc);
        REPS(40) { att::Bufs AB{MB.SQ, MB.SK, nullptr, MB.SV, Y}; if (anu > 0) att::att_phase<true>(au0, anu, AB, (char*)lds + RING_OFF, sink); }
        if (BOTH(4)) GRID_BAR(); }
    if (IN(5)) {
        const int upc = (1024 + F.G - 1) / F.G, au0 = F.vcu * upc, anu = au0 >= 1024 ? 0 : (1024 - au0 < upc ? 1024 - au0 : upc);
        REPS(5) { att::Bufs AB{MB.QM, MB.KN, MB.KPE, MB.VM, Y}; if (anu > 0) att::att_phase<false>(au0, anu, AB, (char*)lds + RING_OFF, nullptr); }
        if (BOTH(5)) GRID_BAR(); }
    if (IN(6)) { pg8::Gemm g{Y, (const bf16*)(ws + WS_WO), M, D, D}; pg8::StaticOrder S; S.init(M, D, D, F.G, (int)blockIdx.x);
        { pg8::EpiRes E{XB, XB, nullptr, ss2, 1.0f, F.lds + RING_OFF};
        pg8::gemm_phase<pg8::EpiRes, pg8::StaticOrder, true, true>(F.lds + RING_OFF, g, S, E); }
        if (MK_DUP == 6) { pg8::EpiRes E{XB, (bf16*)(ws + WS_HID), nullptr, nullptr, 0.f, F.lds + RING_OFF};
        pg8::gemm_phase<pg8::EpiRes, pg8::StaticOrder, true, true>(F.lds + RING_OFF, g, S, E); }
        if (BOTH(6)) GRID_BAR(); }
    if (IN(7)) { pg8::Gemm g{XB, (const bf16*)(ws + WS_W2GU), M, NGU, D}; pg8::StatOrder<pg8::StaticOrder> S; S.S.init(M, NGU, D, F.G, (int)blockIdx.x); S.ssA = ss2; S.ssB = ss2; S.pnB = 1 << 30; S.lds = F.lds;
        pg8::EpiSwiGLU E{HID, F.lds, FF};
        pg8::gemm_phase<pg8::EpiSwiGLU, pg8::StatOrder<pg8::StaticOrder>, MK_ALIGN_GU, true>(F.lds + RING_OFF, g, S, E);
        if (BOTH(7)) GRID_BAR(); }
    if (IN(8)) { pg8::Gemm g{HID, (const bf16*)(ws + WS_W2D), M, D, FF}; pg8::StaticOrder S; S.init(M, D, FF, F.G, (int)blockIdx.x);
        pg8::EpiRes E{XB, nullptr, args.out, nullptr, 0.5f, F.lds + RING_OFF};
        pg8::gemm_phase<pg8::EpiRes, pg8::StaticOrder, true, true>(F.lds + RING_OFF, g, S, E); }
#undef IN
#undef BOTH
#undef GRID_BAR
}

extern "C" void kernel_launch(void* const* d_in, const int* in_sizes, int n_in, void* d_out, int out_size, void* d_ws, size_t ws_size, hipStream_t stream) {
    static int grid = 0;
    if (grid == 0) {
        if (n_in != 23 || in_sizes[0] != M * D || out_size != M * D || ws_size < WS_END) { fprintf(stderr, "kernel_launch: unexpected shapes (n_in %d, in0 %d, out %d, ws %zu); nothing launched\n", n_in, n_in > 0 ? in_sizes[0] : -1, out_size, ws_size); grid = -1; return; }
        int dev = 0, cus = 0, per_cu = 0;
        if (hipGetDevice(&dev) != hipSuccess || hipDeviceGetAttribute(&cus, hipDeviceAttributeMultiprocessorCount, dev) != hipSuccess) { grid = -1; return; }
        if (hipFuncSetAttribute((const void*)mk_fwd, hipFuncAttributeMaxDynamicSharedMemorySize, LDS_BYTES) != hipSuccess) { fprintf(stderr, "kernel_launch: hipFuncSetAttribute failed\n"); grid = -1; return; }
        if (hipOccupancyMaxActiveBlocksPerMultiprocessor(&per_cu, (const void*)mk_fwd, NWAVES * 64, LDS_BYTES) != hipSuccess || per_cu < 1) { fprintf(stderr, "kernel_launch: occupancy query reports %d workgroups per CU\n", per_cu); }
        (void)hipGetLastError();
        grid = cus;
    }
    if (grid < 0) return;
    if (hipMemsetAsync((char*)d_ws + WS_CTL, 0, CTL_ZERO_BYTES, stream) != hipSuccess) return;
    Args a{};
    for (int i = 0; i < 23; ++i) a.in[i] = (const float*)d_in[i];
    a.out = (float*)d_out; a.ws = (unsigned char*)d_ws;
    if (N_LAUNCHES == PER_PHASE) {
        for (int li = 0; li < PER_PHASE; ++li) { a.ph_lo = li; a.ph_hi = li + 1; a.li = li; hipLaunchKernelGGL(mk_fwd, dim3(grid), dim3(NWAVES * 64), LDS_BYTES, stream, a); }
    } else {
        a.ph_lo = 0; a.ph_hi = PER_PHASE; a.li = 0;
        hipLaunchKernelGGL(mk_fwd, dim3(grid), dim3(NWAVES * 64), LDS_BYTES, stream, a);
    }
}
```

```cpp
#include <hip/hip_runtime.h>
#include <hip/hip_bf16.h>
#include <cstdio>
#include <cstdint>
#include <cmath>

#ifndef MK_N_LAUNCHES
#define MK_N_LAUNCHES 1
#endif
#ifndef MK_ALIGN_GU
#define MK_ALIGN_GU true
#endif
#ifndef MK_TST
#define MK_TST 1
#endif
#ifndef MK_TST_GU
#define MK_TST_GU 0
#endif
#ifndef MK_TLD
#define MK_TLD 1
#endif
#ifndef MK_IMG128
#define MK_IMG128 1
#endif
#ifndef MK_DUP
#define MK_DUP -1
#endif
#define REPS(k) for (int rep = 0; rep < ((MK_DUP == (k)) ? 2 : 1); ++rep)

namespace pg8 {
#define PG8_LAS __attribute__((address_space(3)))
typedef unsigned short bf16_t;
typedef short bf16x8 __attribute__((ext_vector_type(8)));
typedef float f32x4 __attribute__((ext_vector_type(4)));
typedef unsigned u32x4 __attribute__((ext_vector_type(4)));
constexpr int BM = 256, BK = 64, HALF = 128, HTB = HALF * BK * 2  , STAGE_BYTES = 8 * HTB, NXCD = 8, WGM = 8;
constexpr float RMS_EPS = 1e-6f;
constexpr float LOG2E = 1.4426950408889634f;

#if MK_IMG128
__host__ __device__ __forceinline__ int lds_byte(int r, int c) { const int rr = r & 7; return (r >> 3) * 1024 + rr * 128 + (((c >> 3) ^ rr) * 16) + (c & 7) * 2; }
__host__ __device__ __forceinline__ void stage_rc(int b, int& R, int& C) { const int st = b / 1024, sb = b % 1024, rr = sb >> 7; R = st * 8 + rr; C = ((((sb >> 4) & 7) ^ rr) << 3) + ((sb & 15) >> 1); }
#define PG8_KOFF(off, k) ((off) ^ ((k) * 64))
#else
__host__ __device__ __forceinline__ int lds_byte(int r, int c) { const int st = (r >> 4) * 2 + (c >> 5), rr = r & 15, cc = c & 31, ob = rr * 64 + cc * 2; return st * 1024 + (ob ^ (((ob >> 9) & 1) << 5)); }
__host__ __device__ __forceinline__ void stage_rc(int b, int& R, int& C) { const int st = b / 1024, sb = b % 1024, swz = sb ^ (((sb >> 9) & 1) << 5); R = (st >> 1) * 16 + swz / 64; C = (st & 1) * 32 + (swz % 64) / 2; }
#define PG8_KOFF(off, k) ((off) + (k) * 1024)
#endif
__host__ __device__ __forceinline__ int perm32(int rho) { const int n = rho >> 4, i = rho & 15; return 8 * (i >> 2) + 4 * n + (i & 3); }

struct Unit { int pm, pn, koff, nt, par; };
struct Gemm { const bf16_t* A; const bf16_t* Bt; int M, N, K; };

struct StaticOrder {
    int nM, nN, nwg, G, c, nt;
    __host__ __device__ void init(int M, int N, int K, int G_, int c_) { nM = M / BM; nN = N / BM; nwg = nM * nN; G = G_; c = c_; nt = K / BK; }
    __host__ __device__ bool next(int i, Unit& u) const {
        const long L = (long)i * G + c; if (L >= nwg) return false;
        int wgid = (int)L; { const int q = nwg / NXCD, r = nwg % NXCD, xcd = wgid % NXCD, off = wgid / NXCD; wgid = (xcd < r ? xcd * (q + 1) : r * (q + 1) + (xcd - r) * q) + off; }
        const int nig = WGM * nN, gid = wgid / nig, fm = gid * WGM, gsz = (nM - fm) < WGM ? (nM - fm) : WGM;
        u.pm = fm + ((wgid % nig) % gsz); u.pn = (wgid % nig) / gsz; u.koff = 0; u.nt = nt; u.par = i & 1; return true;
    }
    __device__ __forceinline__ void a_ready(const Unit&) const {}
    __device__ __forceinline__ void done(const Unit&) const {}
};

struct UpOrder {
    StaticOrder S;
    __device__ bool next(int i, Unit& u) const { if (!S.next(i, u)) return false; if (u.pn < 3) { u.koff = 0; u.nt = 4; } else { u.koff = 256 * 2; u.nt = 2; } return true; }
    __device__ __forceinline__ void a_ready(const Unit&) const {}
    __device__ __forceinline__ void done(const Unit&) const {}
};

constexpr int SSB_OFF = STAGE_BYTES + 2048;
template <class Base> struct StatOrder {
    Base S; const float* ssA; const float* ssB; int pnB;
    PG8_LAS unsigned char* lds;
    __device__ bool next(int i, Unit& u) const { return S.next(i, u); }
    __device__ __forceinline__ void a_ready(const Unit& u) const {
        const int tid = threadIdx.x, w = __builtin_amdgcn_readfirstlane(tid >> 6);
        if (w < 4) { const float* src = (u.pn < pnB ? ssA : ssB) + u.pm * BM + tid;
            __builtin_amdgcn_global_load_lds((const unsigned*)src, (PG8_LAS unsigned*)(lds + SSB_OFF + u.par * 1024 + w * 256), 4, 0, 0); }
    }
    __device__ __forceinline__ void done(const Unit&) const {}
};
__device__ __forceinline__ void lds_rows8(float (&v)[2][4], PG8_LAS unsigned char* lds, const Unit& u, int wr, int fr) {
    const PG8_LAS float* p = (const PG8_LAS float*)(lds + SSB_OFF + u.par * 1024) + wr * 64 + fr;
#pragma unroll
    for (int ai = 0; ai < 2; ++ai)
#pragma unroll
        for (int m = 0; m < 4; ++m) v[ai][m] = p[ai * HALF + m * 16];
}

__device__ __forceinline__ unsigned cvt_pk_bf16(float lo, float hi) { unsigned r; asm volatile("v_cvt_pk_bf16_f32 %0, %1, %2" : "=v"(r) : "v"(lo), "v"(hi)); return r; }
__device__ __forceinline__ u32x4 pack8(const f32x4 a, const f32x4 b) { u32x4 w; w.x = cvt_pk_bf16(a[0], a[1]); w.y = cvt_pk_bf16(a[2], a[3]); w.z = cvt_pk_bf16(b[0], b[1]); w.w = cvt_pk_bf16(b[2], b[3]); return w; }
struct TSt { PG8_LAS unsigned char* a0; PG8_LAS unsigned char* a1; int wofs, rofs, wofs32, rofs32, drow, c3, fr, fq, lane; };
__device__ __forceinline__ TSt tst_init(PG8_LAS unsigned char* lds, int wr, int wc, int fr, int fq) {
    const int wid = wr * 4 + wc, lane = fr + 16 * fq; TSt t;
    t.a0 = lds + 3 * HTB + wid * 1024; t.a1 = t.a0 + 8192;
    t.wofs = fr * 64 + ((fq ^ ((fr >> 1) & 3)) * 16); t.rofs = (lane >> 2) * 64 + (((lane & 3) ^ ((lane >> 3) & 3)) * 16);
    t.wofs32 = (fr & 7) * 128 + (((2 * fq) ^ (fr & 7)) * 16); t.rofs32 = (lane >> 3) * 128 + (((lane & 7) ^ (lane >> 3)) * 16);
    t.drow = (lane >> 2) - fr; t.c3 = 8 * (lane & 3); t.fr = fr; t.fq = fq; t.lane = lane; return t; }
__device__ __forceinline__ void tst16(const TSt& t, int sel, const u32x4 w, bf16_t* P, int pitch) {
#if MK_TST
    PG8_LAS unsigned char* a = sel ? t.a1 : t.a0;
    *(PG8_LAS u32x4*)(a + t.wofs) = w;
    const u32x4 v = *(const PG8_LAS u32x4*)(a + t.rofs);
    *(u32x4*)(P + (long)t.drow * pitch + t.c3) = v;
#else
    *(u32x4*)(P + 8 * t.fq) = w;
#endif
}
__device__ __forceinline__ u32x4 tld16(const TSt& t, int sel, const u32x4 w) {
    PG8_LAS unsigned char* a = sel ? t.a1 : t.a0;
    *(PG8_LAS u32x4*)(a + t.rofs) = w;
    return *(const PG8_LAS u32x4*)(a + t.wofs);
}
__device__ __forceinline__ void tst32f(const TSt& t, const f32x4 v0, const f32x4 v1, float* P, int pitch) {
#if MK_TST
    PG8_LAS unsigned char* aw = ((t.fr & 8) ? t.a1 : t.a0) + t.wofs32;
    *(PG8_LAS f32x4*)(aw) = v0; *(PG8_LAS f32x4*)(((t.fr & 8) ? t.a1 : t.a0) + (t.wofs32 ^ 16)) = v1;
    const f32x4 r0 = *(const PG8_LAS f32x4*)(t.a0 + t.rofs32), r1 = *(const PG8_LAS f32x4*)(t.a1 + t.rofs32);
    float* Q = P + (long)((t.lane >> 3) - t.fr) * pitch + 4 * (t.lane & 7);
    *(f32x4*)Q = r0; *(f32x4*)(Q + (long)8 * pitch) = r1;
#else
    *(f32x4*)(P + 8 * t.fq) = v0; *(f32x4*)(P + 8 * t.fq + 4) = v1;
#endif
}
__device__ __forceinline__ float dot4(const f32x4 a) { return (a[0] * a[0] + a[1] * a[1]) + (a[2] * a[2] + a[3] * a[3]); }
__device__ __forceinline__ float hsum4(f32x4 t) { asm("" : "+v"(t)); return (t[0] + t[1]) + (t[2] + t[3]); }
__device__ __forceinline__ float sumsq8(const f32x4 a, const f32x4 b) { f32x4 t = a * a; t = b * b + t; return hsum4(t); }
__device__ __forceinline__ float sumsq16(const f32x4 a, const f32x4 b, const f32x4 c, const f32x4 d) { f32x4 t = a * a; t = b * b + t; t = c * c + t; t = d * d + t; return hsum4(t); }
__device__ __forceinline__ float sum_fq(float s) {
    const auto a = __builtin_amdgcn_permlane32_swap(__float_as_uint(s), __float_as_uint(s), false, false); s = __uint_as_float(a[0]) + __uint_as_float(a[1]);
    const auto b = __builtin_amdgcn_permlane16_swap(__float_as_uint(s), __float_as_uint(s), false, false); return __uint_as_float(b[0]) + __uint_as_float(b[1]); }
__device__ __forceinline__ float silu_f(float g) { return g * __builtin_amdgcn_rcpf(1.0f + __builtin_amdgcn_exp2f(-LOG2E * g)); }
__device__ __forceinline__ float rs_of(float ss, float inv_n) { return __builtin_amdgcn_rsqf(ss * inv_n + RMS_EPS); }

__device__ __forceinline__ void load_rows8(float (&v)[2][4], const float* p, int row0) {
#pragma unroll
    for (int ai = 0; ai < 2; ++ai)
#pragma unroll
        for (int m = 0; m < 4; ++m) v[ai][m] = p[row0 + ai * HALF + m * 16];
    asm volatile("" : "+v"(v[0][0]), "+v"(v[0][1]), "+v"(v[0][2]), "+v"(v[0][3]), "+v"(v[1][0]), "+v"(v[1][1]), "+v"(v[1][2]), "+v"(v[1][3]));
}

struct EpiSwiGLU {
    static constexpr bool PERM = true, AFTER_DRAIN = false;
    bf16_t* H; PG8_LAS unsigned char* lds; int ldh;
    __device__ __forceinline__ void operator()(const f32x4 (&acc)[2][2][4][2], const Unit& u, int wr, int wc, int fr, int fq) const {
        asm volatile("" : "+v"(fr), "+v"(fq));
        const int row0 = u.pm * BM + wr * 64 + fr, colb = u.pn * HALF + wc * 32;
        const TSt T = tst_init(lds, wr, wc, fr, fq);
        float sv[2][4]; lds_rows8(sv, lds, u, wr, fr);
#pragma unroll
        for (int ai = 0; ai < 2; ++ai)
#pragma unroll
            for (int m = 0; m < 4; ++m) {
                const int row = row0 + ai * HALF + m * 16;
                const float ir2 = sv[ai][m] * (1.0f / 1024.0f) + RMS_EPS, c = -LOG2E * __builtin_amdgcn_rsqf(ir2);
                f32x4 h[2];
#pragma unroll
                for (int n = 0; n < 2; ++n) { const f32x4 g = acc[ai][0][m][n], up = acc[ai][1][m][n]; const f32x4 t = g * c; f32x4 e, w;
#pragma unroll
                    for (int i = 0; i < 4; ++i) e[i] = __builtin_amdgcn_exp2f(t[i]);
                    const f32x4 d = e * ir2 + ir2;
#pragma unroll
                    for (int i = 0; i < 4; ++i) w[i] = __builtin_amdgcn_rcpf(d[i]);
                    h[n] = (g * up) * w; }
                if (MK_TST_GU) tst16(T, m & 1, pack8(h[0], h[1]), H + (size_t)row * ldh + colb, ldh);
                else *(u32x4*)(H + (size_t)row * ldh + colb + 8 * fq) = pack8(h[0], h[1]);
            }
    }
};

__device__ __forceinline__ void unpack8(const u32x4 w, f32x4& a, f32x4& b) {
    a[0] = __uint_as_float(w.x << 16); a[1] = __uint_as_float(w.x & 0xffff0000u); a[2] = __uint_as_float(w.y << 16); a[3] = __uint_as_float(w.y & 0xffff0000u);
    b[0] = __uint_as_float(w.z << 16); b[1] = __uint_as_float(w.z & 0xffff0000u); b[2] = __uint_as_float(w.w << 16); b[3] = __uint_as_float(w.w & 0xffff0000u); }
struct EpiRes {
    static constexpr bool PERM = true, AFTER_DRAIN = false;
    const bf16_t* base; bf16_t* xb; float* outf; float* ss; float alpha; PG8_LAS unsigned char* lds;
    __device__ __forceinline__ void operator()(const f32x4 (&acc)[2][2][4][2], const Unit& u, int wr, int wc, int fr, int fq) const {
        asm volatile("" : "+v"(fr), "+v"(fq));
        const int row0 = u.pm * BM + wr * 64 + fr, col0 = u.pn * BM + wc * 32 + 8 * fq, colb = u.pn * BM + wc * 32;
        const TSt T = tst_init(lds, wr, wc, fr, fq);
        u32x4 b[2][4][2];
#pragma unroll
        for (int ai = 0; ai < 2; ++ai)
#pragma unroll
            for (int m = 0; m < 4; ++m) { const size_t off = (size_t)(row0 + ai * HALF + m * 16) * 1024 + col0;
#pragma unroll
                for (int bj = 0; bj < 2; ++bj) b[ai][m][bj] = MK_TLD ? *(const u32x4*)(base + (size_t)(row0 + ai * HALF + m * 16 + T.drow) * 1024 + colb + bj * HALF + T.c3)
                                                                     : *(const u32x4*)(base + off + bj * HALF); }
#pragma unroll
        for (int ai = 0; ai < 2; ++ai)
#pragma unroll
            for (int m = 0; m < 4; ++m) asm volatile("" : "+v"(b[ai][m][0]), "+v"(b[ai][m][1]));
#pragma unroll
        for (int ai = 0; ai < 2; ++ai) {
#pragma unroll
            for (int m = 0; m < 4; ++m) { const int row = row0 + ai * HALF + m * 16; const size_t off = (size_t)row * 1024 + col0; float s = 0.f;
#pragma unroll
                for (int bj = 0; bj < 2; ++bj) { f32x4 b0, b1; unpack8(MK_TLD ? tld16(T, bj, b[ai][m][bj]) : b[ai][m][bj], b0, b1);
                    const f32x4 v0 = b0 + acc[ai][bj][m][0] * alpha, v1 = b1 + acc[ai][bj][m][1] * alpha;
                    if (outf) tst32f(T, v0, v1, outf + (size_t)row * 1024 + colb + bj * HALF, 1024);
                    if (xb) tst16(T, bj, pack8(v0, v1), xb + (size_t)row * 1024 + colb + bj * HALF, 1024);
                    s += sumsq8(v0, v1); }
                if (ss) { s = sum_fq(s); if (fq == 0) unsafeAtomicAdd(ss + row, s); } }
        }
    }
};

struct EpiNull {
    static constexpr bool PERM = true, AFTER_DRAIN = false;
    __device__ __forceinline__ void operator()(const f32x4 (&acc)[2][2][4][2], const Unit&, int, int, int, int) const {
#pragma unroll
        for (int ai = 0; ai < 2; ++ai)
#pragma unroll
            for (int bj = 0; bj < 2; ++bj)
#pragma unroll
                for (int m = 0; m < 4; ++m) asm volatile("" :: "v"(acc[ai][bj][m][0]), "v"(acc[ai][bj][m][1]));
    }
};

struct MixBufs {
    bf16_t *HQKV, *KPE, *SQ, *SK, *SV, *QM, *KN, *VM;
    float *ssq, *sskv; const float *ss1;
    const float *g_kr, *g_sq, *g_sk, *g_qn, *g_qr, *g_kn;
    const float *rcos, *rsin;
    int noatom;
};
constexpr float C_SWA = 0.125f * LOG2E;
constexpr float C_MLA = 0.10206207261596577f * LOG2E;

__device__ __forceinline__ void head64_norm_store(const f32x4 v00, const f32x4 v01, const f32x4 v10, const f32x4 v11, float r, const f32x4 (&g)[2][2], float post, bf16_t* dst, int pitch, const TSt& T) {
    const float s = sum_fq(sumsq16(v00, v01, v10, v11));
    const float rr = rs_of(s * (r * r), 1.0f / 64.0f) * (r * post);
    tst16(T, 0, pack8(v00 * rr * g[0][0], v01 * rr * g[0][1]), dst, pitch);
    tst16(T, 1, pack8(v10 * rr * g[1][0], v11 * rr * g[1][1]), dst + 32, pitch);
}
__device__ __forceinline__ void rope32_norm_store_cs(f32x4 x1, f32x4 x2, float r, const f32x4 g1, const f32x4 g2, const f32x4 cs, const f32x4 sn, float post, bf16_t* dst, int pitch, const TSt& T) {
    const float s = sum_fq(sumsq8(x1, x2));
    const float rr = rs_of(s * (r * r), 1.0f / 32.0f) * (r * post);
    x1 = x1 * rr * g1; x2 = x2 * rr * g2;
    const f32x4 o1 = x1 * cs - x2 * sn, o2 = x2 * cs + x1 * sn;
    tst16(T, 0, pack8(o1, o2), dst, pitch);
}
__device__ __forceinline__ void load_rope4(f32x4 (&cs)[4], f32x4 (&sn)[4], const float* rcos, const float* rsin, int rowa, int fq) {
#pragma unroll
    for (int m = 0; m < 4; ++m) { const int pos = (rowa + m * 16) & 2047; cs[m] = *(const f32x4*)(rcos + pos * 16 + 4 * fq); sn[m] = *(const f32x4*)(rsin + pos * 16 + 4 * fq); }
#pragma unroll
    for (int m = 0; m < 4; ++m) asm volatile("" : "+v"(cs[m]), "+v"(sn[m]));
}
__device__ __forceinline__ void load_g64(f32x4 (&g)[2][2], const float* gp, int fq) {
#pragma unroll
    for (int bj = 0; bj < 2; ++bj)
#pragma unroll
        for (int n = 0; n < 2; ++n) g[bj][n] = *(const f32x4*)(gp + 32 * bj + 8 * fq + 4 * n);
}

struct EpiWin {
    static constexpr bool PERM = true, AFTER_DRAIN = false;
    MixBufs B; PG8_LAS unsigned char* lds;
    __device__ __forceinline__ void operator()(const f32x4 (&acc)[2][2][4][2], const Unit& u, int wr, int wc, int fr, int fq) const {
        asm volatile("" : "+v"(fr), "+v"(fq));
        const int row0 = u.pm * BM + wr * 64 + fr; const int pn = u.pn;
        const TSt T = tst_init(lds, wr, wc, fr, fq);
        float sv[2][4]; lds_rows8(sv, lds, u, wr, fr);
        if (pn == 0) {
#pragma unroll
            for (int ai = 0; ai < 2; ++ai)
#pragma unroll
                for (int m = 0; m < 4; ++m) { const int row = row0 + ai * HALF + m * 16; const float r = rs_of(sv[ai][m], 1.0f / 1024.0f); float s = 0.f;
#pragma unroll
                    for (int bj = 0; bj < 2; ++bj) { const f32x4 v0 = acc[ai][bj][m][0] * r, v1 = acc[ai][bj][m][1] * r; s += sumsq8(v0, v1);
                        tst16(T, bj, pack8(v0, v1), B.HQKV + (size_t)row * 384 + bj * HALF + wc * 32, 384); }
                    s = sum_fq(s); if (fq == 0 && !B.noatom) unsafeAtomicAdd(B.ssq + row, s); }
        } else if (pn == 1) {
            const f32x4 g1 = *(const f32x4*)(B.g_kr + 4 * fq), g2 = *(const f32x4*)(B.g_kr + 16 + 4 * fq);
#pragma unroll
            for (int ai = 0; ai < 2; ++ai) {
                f32x4 cs[4], sn[4]; if (wc == 0) load_rope4(cs, sn, B.rcos, B.rsin, row0 + ai * HALF, fq);
#pragma unroll
                for (int m = 0; m < 4; ++m) { const int row = row0 + ai * HALF + m * 16; const float r = rs_of(sv[ai][m], 1.0f / 1024.0f);
                    const f32x4 v0 = acc[ai][0][m][0] * r, v1 = acc[ai][0][m][1] * r;
                    tst16(T, 0, pack8(v0, v1), B.HQKV + (size_t)row * 384 + 256 + wc * 32, 384);
                    const float s = sum_fq(sumsq8(v0, v1)); if (fq == 0 && !B.noatom) unsafeAtomicAdd(B.sskv + row, s);
                    if (wc == 0) rope32_norm_store_cs(acc[ai][1][m][0], acc[ai][1][m][1], r, g1, g2, cs[m], sn[m], 1.0f, B.KPE + (size_t)row * 32, 32, T); } }
        } else if (pn < 4) {
            f32x4 g[2][2]; load_g64(g, B.g_sq, fq); const int head = 4 * (pn - 2) + wc;
#pragma unroll
            for (int ai = 0; ai < 2; ++ai)
#pragma unroll
                for (int m = 0; m < 4; ++m) { const int row = row0 + ai * HALF + m * 16; const float r = rs_of(sv[ai][m], 1.0f / 1024.0f);
                    head64_norm_store(acc[ai][0][m][0], acc[ai][0][m][1], acc[ai][1][m][0], acc[ai][1][m][1], r, g, C_SWA, B.SQ + (size_t)row * 512 + head * 64, 512, T); }
        } else {
            if (wc < 2) { f32x4 g[2][2]; load_g64(g, B.g_sk, fq);
#pragma unroll
                for (int ai = 0; ai < 2; ++ai)
#pragma unroll
                    for (int m = 0; m < 4; ++m) { const int row = row0 + ai * HALF + m * 16; const float r = rs_of(sv[ai][m], 1.0f / 1024.0f);
                        head64_norm_store(acc[ai][0][m][0], acc[ai][0][m][1], acc[ai][1][m][0], acc[ai][1][m][1], r, g, 1.0f, B.SK + (size_t)row * 128 + wc * 64, 128, T); }
            } else {
#pragma unroll
                for (int ai = 0; ai < 2; ++ai)
#pragma unroll
                    for (int m = 0; m < 4; ++m) { const int row = row0 + ai * HALF + m * 16; const float r = rs_of(sv[ai][m], 1.0f / 1024.0f); bf16_t* dst = B.SV + (size_t)row * 128 + (wc - 2) * 64;
                        tst16(T, 0, pack8(acc[ai][0][m][0] * r, acc[ai][0][m][1] * r), dst, 128); tst16(T, 1, pack8(acc[ai][1][m][0] * r, acc[ai][1][m][1] * r), dst + 32, 128); }
            }
        }
    }
};

struct EpiUp {
    static constexpr bool PERM = true, AFTER_DRAIN = false;
    MixBufs B; PG8_LAS unsigned char* lds;
    __device__ __forceinline__ void operator()(const f32x4 (&acc)[2][2][4][2], const Unit& u, int wr, int wc, int fr, int fq) const {
        asm volatile("" : "+v"(fr), "+v"(fq));
        const int row0 = u.pm * BM + wr * 64 + fr; const int pn = u.pn;
        const TSt T = tst_init(lds, wr, wc, fr, fq);
        float sv[2][4]; lds_rows8(sv, lds, u, wr, fr);
        if (pn < 2) {
            f32x4 g[2][2]; load_g64(g, B.g_qn, fq); const int head = 4 * pn + wc;
#pragma unroll
            for (int ai = 0; ai < 2; ++ai)
#pragma unroll
                for (int m = 0; m < 4; ++m) { const int row = row0 + ai * HALF + m * 16; const float r = rs_of(sv[ai][m], 1.0f / 256.0f);
                    head64_norm_store(acc[ai][0][m][0], acc[ai][0][m][1], acc[ai][1][m][0], acc[ai][1][m][1], r, g, C_MLA, B.QM + (size_t)row * 768 + head * 96, 768, T); }
        } else if (pn == 2) {
            const f32x4 g1 = *(const f32x4*)(B.g_qr + 4 * fq), g2 = *(const f32x4*)(B.g_qr + 16 + 4 * fq);
#pragma unroll
            for (int ai = 0; ai < 2; ++ai) {
                f32x4 cs[4], sn[4]; load_rope4(cs, sn, B.rcos, B.rsin, row0 + ai * HALF, fq);
#pragma unroll
                for (int m = 0; m < 4; ++m) { const int row = row0 + ai * HALF + m * 16; const float r = rs_of(sv[ai][m], 1.0f / 256.0f);
#pragma unroll
                    for (int bj = 0; bj < 2; ++bj) rope32_norm_store_cs(acc[ai][bj][m][0], acc[ai][bj][m][1], r, g1, g2, cs[m], sn[m], C_MLA, B.QM + (size_t)row * 768 + (4 * bj + wc) * 96 + 64, 768, T); } }
        } else if (pn < 5) {
            f32x4 g[2][2]; load_g64(g, B.g_kn, fq); const int head = 4 * (pn - 3) + wc;
#pragma unroll
            for (int ai = 0; ai < 2; ++ai)
#pragma unroll
                for (int m = 0; m < 4; ++m) { const int row = row0 + ai * HALF + m * 16; const float r = rs_of(sv[ai][m], 1.0f / 128.0f);
                    head64_norm_store(acc[ai][0][m][0], acc[ai][0][m][1], acc[ai][1][m][0], acc[ai][1][m][1], r, g, 1.0f, B.KN + (size_t)row * 512 + head * 64, 512, T); }
        } else {
            const int head = 4 * (pn - 5) + wc;
#pragma unroll
            for (int ai = 0; ai < 2; ++ai)
#pragma unroll
                for (int m = 0; m < 4; ++m) { const int row = row0 + ai * HALF + m * 16; const float r = rs_of(sv[ai][m], 1.0f / 128.0f); bf16_t* dst = B.VM + (size_t)row * 512 + head * 64;
                    tst16(T, 0, pack8(acc[ai][0][m][0] * r, acc[ai][0][m][1] * r), dst, 512); tst16(T, 1, pack8(acc[ai][1][m][0] * r, acc[ai][1][m][1] * r), dst + 32, 512); }
        }
    }
};

template <class Epi, class Sched, bool ALIGN_EPI = false, bool SP2 = false>
__device__ __forceinline__ void gemm_phase(PG8_LAS unsigned char* lds, const Gemm g, const Sched& S, const Epi& E) {
    const int tid = threadIdx.x, wid = __builtin_amdgcn_readfirstlane(tid >> 6), lane = tid & 63, wr = wid >> 2, wc = wid & 3, fr = lane & 15, fq = lane >> 4;
    const int K = g.K;
    unsigned voffA[2], voffB[2];
#pragma unroll
    for (int i = 0; i < 2; ++i) { int R, C; stage_rc(tid * 16 + i * 8192, R, C); const int Rb = Epi::PERM ? ((R & ~31) + perm32(R & 31)) : R;
        voffA[i] = (unsigned)(R * K + C) * 2u; voffB[i] = (unsigned)(Rb * K + C) * 2u; }
    const size_t kstep = (size_t)(BK * 2);
    const size_t hstep = (size_t)HALF * K * 2;
    const size_t tstep = 2 * hstep;
    const unsigned ldsw = (unsigned)wid * 1024u;
    const int aoff = lds_byte(wr * 64 + fr, fq * 8), boff = lds_byte(wc * 32 + fr, fq * 8);
#define PG8_SA(b, h) (((b) * 2 + (h)) * HTB)
#define PG8_SB(b, h) ((4 + (b) * 2 + (h)) * HTB)
#define PG8_STAGE(bufoff, gbase, voff) do { _Pragma("unroll") for (int _i = 0; _i < 2; ++_i) \
        __builtin_amdgcn_global_load_lds((const unsigned*)((const char*)(gbase) + (voff)[_i]), (PG8_LAS unsigned*)(lds + (bufoff) + ldsw + _i * 8192), 16, 0, 0); } while (0)
#define PG8_LDA(dst, b, h) do { _Pragma("unroll") for (int m = 0; m < 4; ++m) _Pragma("unroll") for (int k = 0; k < 2; ++k) dst[m][k] = *(const PG8_LAS bf16x8*)(lds + PG8_SA(b, h) + PG8_KOFF(aoff, k) + m * 2048); } while (0)
#define PG8_LDB(dst, b, h) do { _Pragma("unroll") for (int n = 0; n < 2; ++n) _Pragma("unroll") for (int k = 0; k < 2; ++k) dst[n][k] = *(const PG8_LAS bf16x8*)(lds + PG8_SB(b, h) + PG8_KOFF(boff, k) + n * 2048); } while (0)
#define PG8_MMA(ai, bj, At, Bt) do { __builtin_amdgcn_s_setprio(1); _Pragma("unroll") for (int m = 0; m < 4; ++m) _Pragma("unroll") for (int n = 0; n < 2; ++n) _Pragma("unroll") for (int k = 0; k < 2; ++k) \
        acc[ai][bj][m][n] = __builtin_amdgcn_mfma_f32_16x16x32_bf16(Bt[n][k], At[m][k], acc[ai][bj][m][n], 0, 0, 0); __builtin_amdgcn_s_setprio(0); } while (0)
#define PG8_WAIT_V(n) asm volatile("s_waitcnt vmcnt(" #n ")" ::: "memory")
#define PG8_WAIT_L(n) asm volatile("s_waitcnt lgkmcnt(" #n ")" ::: "memory")
#define PG8_BAR __builtin_amdgcn_s_barrier()
#define PG8_SCHED __builtin_amdgcn_sched_barrier(0)
    Unit cur, nxt; int ui = 0;
    if (!S.next(0, cur)) return;
    f32x4 acc[2][2][4][2];
#pragma unroll
    for (int a = 0; a < 2; ++a)
#pragma unroll
        for (int b = 0; b < 2; ++b)
#pragma unroll
            for (int m = 0; m < 4; ++m)
#pragma unroll
                for (int n = 0; n < 2; ++n) acc[a][b][m][n] = (f32x4){0.f, 0.f, 0.f, 0.f};
    bf16x8 At[4][2], B0[2][2], B1[2][2];
    const char* cA = (const char*)g.A + (size_t)cur.pm * tstep + cur.koff; const char* cB = (const char*)g.Bt + (size_t)cur.pn * tstep + cur.koff;
    S.a_ready(cur);
    if constexpr (SP2) {
        PG8_STAGE(PG8_SB(0, 0), cB, voffB); PG8_STAGE(PG8_SB(0, 1), cB + hstep, voffB); PG8_STAGE(PG8_SA(0, 0), cA, voffA); PG8_STAGE(PG8_SA(0, 1), cA + hstep, voffA);
        if (wr == 1) PG8_BAR;
        PG8_WAIT_V(2); PG8_BAR;
        PG8_STAGE(PG8_SB(1, 0), cB + kstep, voffB); PG8_STAGE(PG8_SA(1, 0), cA + kstep, voffA); PG8_STAGE(PG8_SB(1, 1), cB + hstep + kstep, voffB);
        PG8_WAIT_V(6); PG8_BAR;
    } else {
        PG8_STAGE(PG8_SB(0, 0), cB, voffB); PG8_STAGE(PG8_SA(0, 0), cA, voffA); PG8_STAGE(PG8_SB(0, 1), cB + hstep, voffB); PG8_STAGE(PG8_SA(0, 1), cA + hstep, voffA);
        if (wr == 1) PG8_BAR;
        PG8_WAIT_V(4); PG8_BAR;
        PG8_STAGE(PG8_SB(1, 0), cB + kstep, voffB); PG8_STAGE(PG8_SA(1, 0), cA + kstep, voffA); PG8_STAGE(PG8_SB(1, 1), cB + hstep + kstep, voffB);
        PG8_WAIT_V(6); PG8_BAR;
    }
    for (;;) {
        const bool has_next = S.next(ui + 1, nxt);
        const char* nA = has_next ? (const char*)g.A + (size_t)nxt.pm * tstep + nxt.koff : cA; const char* nB = has_next ? (const char*)g.Bt + (size_t)nxt.pn * tstep + nxt.koff : cB;
        const int nt = cur.nt;
#pragma unroll 1
        for (int t = 0; t < nt; t += 2) {
            const bool last = (t == nt - 2);
            const char* a1 = cA + (size_t)(t + 1) * kstep;
            const char* a2 = last ? nA : cA + (size_t)(t + 2) * kstep; const char* b2 = last ? nB : cB + (size_t)(t + 2) * kstep;
            const char* a3 = a2 + kstep; const char* b3 = b2 + kstep;
            if (last && has_next) S.a_ready(nxt);
            if constexpr (SP2) {
            PG8_LDB(B0, 0, 0); PG8_LDB(B1, 0, 1); PG8_SCHED; PG8_LDA(At, 0, 0); PG8_STAGE(PG8_SA(1, 1), a1 + hstep, voffA);
            PG8_WAIT_V(8); PG8_WAIT_L(0); PG8_BAR; PG8_MMA(0, 0, At, B0); PG8_MMA(0, 1, At, B1); PG8_BAR; PG8_SCHED;
            PG8_LDA(At, 0, 1); PG8_STAGE(PG8_SB(0, 0), b2, voffB); PG8_STAGE(PG8_SB(0, 1), b2 + hstep, voffB); PG8_STAGE(PG8_SA(0, 0), a2, voffA);
            PG8_WAIT_V(8); PG8_WAIT_L(0); PG8_BAR; PG8_MMA(1, 0, At, B0); PG8_MMA(1, 1, At, B1); PG8_BAR; PG8_SCHED;
            PG8_LDB(B0, 1, 0); PG8_LDB(B1, 1, 1); PG8_SCHED; PG8_LDA(At, 1, 0); PG8_STAGE(PG8_SA(0, 1), a2 + hstep, voffA);
            PG8_WAIT_V(8); PG8_WAIT_L(0); PG8_BAR; PG8_MMA(0, 0, At, B0); PG8_MMA(0, 1, At, B1); PG8_BAR; PG8_SCHED;
            PG8_LDA(At, 1, 1); PG8_STAGE(PG8_SB(1, 0), b3, voffB); PG8_STAGE(PG8_SB(1, 1), b3 + hstep, voffB); PG8_STAGE(PG8_SA(1, 0), a3, voffA);
            PG8_WAIT_V(8); PG8_WAIT_L(0); PG8_BAR; PG8_MMA(1, 0, At, B0); PG8_MMA(1, 1, At, B1); PG8_BAR; PG8_SCHED;
            } else {
            PG8_LDB(B0, 0, 0); PG8_SCHED; PG8_LDA(At, 0, 0); PG8_STAGE(PG8_SA(1, 1), a1 + hstep, voffA);
            PG8_WAIT_L(8); PG8_BAR; PG8_WAIT_L(0); PG8_MMA(0, 0, At, B0); PG8_BAR; PG8_SCHED;
            PG8_LDB(B1, 0, 1); PG8_STAGE(PG8_SB(0, 0), b2, voffB);
            PG8_BAR; PG8_WAIT_L(0); PG8_MMA(0, 1, At, B1); PG8_BAR;
            PG8_LDA(At, 0, 1); PG8_STAGE(PG8_SA(0, 0), a2, voffA);
            PG8_BAR; PG8_WAIT_L(0); PG8_MMA(1, 0, At, B0); PG8_BAR; PG8_SCHED;
            PG8_STAGE(PG8_SB(0, 1), b2 + hstep, voffB);
            PG8_WAIT_V(6); PG8_BAR; PG8_MMA(1, 1, At, B1); PG8_BAR;
            PG8_LDB(B0, 1, 0); PG8_SCHED; PG8_LDA(At, 1, 0); PG8_STAGE(PG8_SA(0, 1), a2 + hstep, voffA);
            PG8_WAIT_L(8); PG8_BAR; PG8_WAIT_L(0); PG8_MMA(0, 0, At, B0); PG8_BAR; PG8_SCHED;
            PG8_LDB(B1, 1, 1); PG8_STAGE(PG8_SB(1, 0), b3, voffB);
            PG8_BAR; PG8_WAIT_L(0); PG8_MMA(0, 1, At, B1); PG8_BAR;
            PG8_LDA(At, 1, 1); PG8_STAGE(PG8_SA(1, 0), a3, voffA);
            PG8_BAR; PG8_WAIT_L(0); PG8_MMA(1, 0, At, B0); PG8_BAR; PG8_SCHED;
            PG8_STAGE(PG8_SB(1, 1), b3 + hstep, voffB);
            PG8_WAIT_V(6); PG8_BAR; PG8_MMA(1, 1, At, B1); PG8_BAR;
            }
        }
        if constexpr (ALIGN_EPI) { if (wr == 0) PG8_BAR; }
        if constexpr (!Epi::AFTER_DRAIN) { E(acc, cur, wr, wc, fr, fq); S.done(cur); }
        if (!has_next) break;
#pragma unroll
        for (int a = 0; a < 2; ++a)
#pragma unroll
            for (int b = 0; b < 2; ++b)
#pragma unroll
                for (int m = 0; m < 4; ++m)
#pragma unroll
                    for (int n = 0; n < 2; ++n) acc[a][b][m][n] = (f32x4){0.f, 0.f, 0.f, 0.f};
        cur = nxt; cA = nA; cB = nB; ++ui;
        if constexpr (ALIGN_EPI) { if (wr == 1) PG8_BAR; }
    }
    PG8_WAIT_V(0);
    if constexpr (!ALIGN_EPI) { if (wr == 0) PG8_BAR; }
    PG8_BAR;
#undef PG8_SA
#undef PG8_SB
#undef PG8_STAGE
#undef PG8_LDA
#undef PG8_LDB
#undef PG8_MMA
#undef PG8_WAIT_V
#undef PG8_WAIT_L
#undef PG8_BAR
#undef PG8_SCHED
}
}

namespace att {
using bf16x8 = __attribute__((ext_vector_type(8))) short;
using s16x4 = __attribute__((ext_vector_type(4))) short;
using f32x16 = __attribute__((ext_vector_type(16))) float;
using u32x4 = __attribute__((ext_vector_type(4))) unsigned;
typedef unsigned short bf16_t;
typedef __attribute__((address_space(3))) const char* lds_cptr;
typedef __attribute__((address_space(3))) char* lds_ptr;
typedef __attribute__((address_space(3))) float* lds_fptr;
typedef short v4i16_t __attribute__((ext_vector_type(4)));
constexpr int SEQ = 2048, QB = 256, KVBLK = 64;
constexpr int KBUF = 12288, VBUF = 8192, LDS_K = 0, LDS_V = 2 * KBUF, LDS_WS = LDS_V + 2 * VBUF, LDS_OST = LDS_WS + 8 * 256, LDS_BYTES = LDS_OST + 8 * 4096;
constexpr float THR = 8.0f, LOG2E_A = 1.4426950408889634f;
__device__ __forceinline__ int crow(int r, int hi) { return (r & 3) + 8 * (r >> 2) + 4 * hi; }
__device__ __forceinline__ void glds16(const void* gsrc, unsigned lds_dst) { unsigned keep;
    asm volatile("s_mov_b32 %0, m0\n\ts_mov_b32 m0, %2\n\ts_nop 0\n\tglobal_load_lds_dwordx4 %1, off\n\ts_mov_b32 m0, %0" : "=&s"(keep) : "v"(gsrc), "s"(lds_dst) : "memory"); }
typedef float f32x2_t __attribute__((ext_vector_type(2))); typedef __bf16 bf16x2_t __attribute__((ext_vector_type(2)));
__device__ __forceinline__ unsigned cvtpk(float lo, float hi) { f32x2_t v = {lo, hi}; bf16x2_t b = __builtin_convertvector(v, bf16x2_t); return __builtin_bit_cast(unsigned, b); }
__device__ __forceinline__ s16x4 vtr(lds_cptr p) { return __builtin_bit_cast(s16x4, __builtin_amdgcn_ds_read_tr16_b64_v4i16((__attribute__((address_space(3))) v4i16_t*)p)); }
__device__ __forceinline__ float fadd_s(float a, float b) { float r = a + b; asm("" : "+v"(r)); return r; }
#define ATT_MX3(a, b, c) __builtin_fmaxf(__builtin_fmaxf((a), (b)), (c))
__device__ __forceinline__ float rowmax(const f32x16& p0, const f32x16& p1) {
    float a = ATT_MX3(p0[0], p0[1], p1[0]), b = ATT_MX3(p0[2], p0[3], p1[1]); a = ATT_MX3(a, p1[2], p1[3]);
#pragma unroll
    for (int r = 4; r < 16; r += 4) { a = ATT_MX3(a, p0[r], p0[r + 1]); b = ATT_MX3(b, p0[r + 2], p0[r + 3]); a = ATT_MX3(a, p1[r], p1[r + 1]); b = ATT_MX3(b, p1[r + 2], p1[r + 3]); }
    float m = __builtin_fmaxf(a, b); auto rr = __builtin_amdgcn_permlane32_swap(__float_as_uint(m), __float_as_uint(m), false, false);
    return __builtin_fmaxf(__uint_as_float(rr[0]), __uint_as_float(rr[1])); }

__device__ __forceinline__ void glds16s(const void* sbase_, unsigned voff, unsigned lds_dst) { unsigned keep;
    const unsigned long long a_ = (unsigned long long)sbase_; const unsigned long long sbase = ((unsigned long long)(unsigned)__builtin_amdgcn_readfirstlane((int)(a_ >> 32)) << 32) | (unsigned)__builtin_amdgcn_readfirstlane((int)a_);
    asm volatile("s_nop 4\n\ts_mov_b32 %0, m0\n\ts_mov_b32 m0, %3\n\ts_nop 0\n\tglobal_load_lds_dwordx4 %1, %2\n\ts_mov_b32 m0, %0" : "=&s"(keep) : "v"(voff), "s"(sbase), "s"(lds_dst) : "memory"); }

struct Bufs { const bf16_t* Q; const bf16_t* K; const bf16_t* KPE; const bf16_t* V; bf16_t* O; };
struct USel { long rowbase; int q0, t0, t1, qcol, kcol, ocol, head0; };

template <bool SWA>
__device__ __forceinline__ void att_phase(const int u0, const int NU, const Bufs B, char* shm, const float* sink) {
    constexpr int ND0 = SWA ? 4 : 6, QP = SWA ? 512 : 768, KP = SWA ? 128 : 512, VP = KP;
    int tid = threadIdx.x; asm volatile("" : "+v"(tid));
    const int lane = tid & 63, r32 = lane & 31, hi = lane >> 5; const int wid = __builtin_amdgcn_readfirstlane(tid >> 6);
    const int hsub = SWA ? (wid & 3) : 0, wrow = SWA ? (wid >> 2) * 32 : wid * 32;
    const unsigned lds0 = (unsigned)(uintptr_t)shm;
    const lds_cptr shm3 = (lds_cptr)shm;
    lds_fptr wsf = (lds_fptr)((lds_ptr)shm + LDS_WS) + wid * 64;
    const unsigned koff = (unsigned)((lane * KP + wid * 8) * 2), peoff = (unsigned)((lane * 32 + wid * 8) * 2);
    const unsigned voff = (unsigned)(((16 * (wid & 3) + (lane >> 2)) * VP + (wid >> 2) * 32 + (lane & 3) * 8) * 2);
    const unsigned kdst = lds0 + LDS_K + wid * 1024, pedst = lds0 + LDS_K + (8 + wid) * 1024, vdst = lds0 + LDS_V + wid * 1024;
    const lds_cptr kp0 = shm3 + LDS_K + hi * 1024 + r32 * 16;
    const lds_cptr vp0 = shm3 + LDS_V + ((lane >> 4) & 1) * 32 + (lane & 3) * 8 + (4 * hi + ((lane & 15) >> 2)) * 64;
    auto decode = [&](int u) { USel s;
        if (SWA) { const int rb = u & 31, kvh = (u >> 5) & 1, b = u >> 6; s.rowbase = (long)b * SEQ; s.q0 = rb * 64; s.t0 = rb - 2 < 0 ? 0 : rb - 2; s.t1 = rb + 3 > SEQ / KVBLK ? SEQ / KVBLK : rb + 3;
                   s.qcol = kvh * 256; s.kcol = kvh * 64; s.ocol = 512 + kvh * 256; s.head0 = kvh * 4; }
        else { const int qb = u & 7, h = (u >> 3) & 7, b = u >> 6; s.rowbase = (long)b * SEQ; s.q0 = qb * QB; s.t0 = 0; s.t1 = SEQ / KVBLK; s.qcol = h * 96; s.kcol = h * 64; s.ocol = h * 64; s.head0 = h; }
        return s; };
#define ATT_DMA(s, t, slot) do { glds16s(B.K + ((s).rowbase + (long)(t) * KVBLK) * KP + (s).kcol, koff, (unsigned)__builtin_amdgcn_readfirstlane(kdst + (slot) * KBUF)); \
        if (!SWA && wid < 4) glds16s(B.KPE + ((s).rowbase + (long)(t) * KVBLK) * 32, peoff, (unsigned)__builtin_amdgcn_readfirstlane(pedst + (slot) * KBUF)); \
        glds16s(B.V + ((s).rowbase + (long)(t) * KVBLK) * VP + (s).kcol, voff, (unsigned)__builtin_amdgcn_readfirstlane(vdst + (slot) * VBUF)); } while (0)
#define ATT_WAIT_BAR() asm volatile("s_waitcnt vmcnt(0) lgkmcnt(0)\n\ts_barrier" ::: "memory")
#define ATT_LOADQ(s) do { const bf16_t* Qw_ = B.Q + ((s).rowbase + (s).q0 + wrow + r32) * QP + (s).qcol + hsub * 64 + hi * 8; \
        _Pragma("unroll") for (int d0 = 0; d0 < ND0; ++d0) qr[d0] = *reinterpret_cast<const bf16x8*>(Qw_ + d0 * 16); } while (0)
    USel cur = decode(u0);
    int slot = 0;
    bf16x8 qr[ND0];
    ATT_DMA(cur, cur.t0, 0);
    ATT_LOADQ(cur);
#pragma unroll 1
    for (int iu = 0; iu < NU; ++iu) {
        const bool has_next = iu + 1 < NU;
        const USel nxt = decode(has_next ? u0 + iu + 1 : u0 + iu);
        const int w0 = cur.q0 + wrow;
        const float slope2 = SWA ? LOG2E_A * __builtin_amdgcn_exp2f(-(float)(cur.head0 + hsub + 1)) : 0.f;
        const float sink2 = SWA ? sink[cur.head0 + hsub] * LOG2E_A : 0.f;
        float mhat = SWA ? sink2 : 0.f, l_reg = SWA ? (hi == 0 ? 1.f : 0.f) : 0.f;
        f32x16 o[2]; o[0] = f32x16{}; o[1] = f32x16{};
        f32x16 negm;
#pragma unroll
        for (int r = 0; r < 16; ++r) negm[r] = -mhat;
        asm volatile("" : "+v"(negm));
        ATT_WAIT_BAR();
        for (int t = cur.t0; t < cur.t1; ++t) {
            const bool active = !SWA || ((t * 64 + 63 >= w0 - 128) && (t * 64 <= w0 + 31 + 128));
            bf16x8 kf[2 * ND0];
            if (active) { const lds_cptr kp = kp0 + slot * KBUF;
#pragma unroll
                for (int d0 = 0; d0 < ND0; ++d0) { kf[2 * d0] = *(const __attribute__((address_space(3))) bf16x8*)(kp + d0 * 2048); kf[2 * d0 + 1] = *(const __attribute__((address_space(3))) bf16x8*)(kp + d0 * 2048 + 512); } }
            __builtin_amdgcn_sched_barrier(0);
            if (t + 1 < cur.t1) ATT_DMA(cur, t + 1, slot ^ 1); else if (has_next) ATT_DMA(nxt, nxt.t0, slot ^ 1);
            if (active) {
                f32x16 p0, p1;
                __builtin_amdgcn_sched_barrier(0);
#pragma unroll
                for (int d0 = 0; d0 < ND0; ++d0) {
                    p0 = __builtin_amdgcn_mfma_f32_32x32x16_bf16(kf[2 * d0], qr[d0], d0 == 0 ? negm : p0, 0, 0, 0);
                    p1 = __builtin_amdgcn_mfma_f32_32x32x16_bf16(kf[2 * d0 + 1], qr[d0], d0 == 0 ? negm : p1, 0, 0, 0);
                }
                __builtin_amdgcn_sched_barrier(0);
                const lds_cptr vp = vp0 + slot * VBUF;
                s16x4 vlo[8], vhi[8];
#pragma unroll
                for (int i = 0; i < 8; ++i) { vlo[i] = vtr(vp + (i >> 2) * 4096 + (i & 3) * 1024); vhi[i] = vtr(vp + (i >> 2) * 4096 + (i & 3) * 1024 + 512); }
                __builtin_amdgcn_sched_barrier(0);
                if (SWA) {
                    const float qf = (float)(w0 + r32 - t * 64 - 4 * hi);
#pragma unroll
                    for (int r = 0; r < 16; ++r) { const float d0 = (float)((r & 3) + 8 * (r >> 2)) - qf, d1 = d0 + 32.0f;
                        p0[r] = (__builtin_fabsf(d0) <= 128.0f) ? __builtin_fmaf(-slope2, __builtin_fabsf(d0), p0[r]) : -INFINITY;
                        p1[r] = (__builtin_fabsf(d1) <= 128.0f) ? __builtin_fmaf(-slope2, __builtin_fabsf(d1), p1[r]) : -INFINITY; }
                }
                const float rm = rowmax(p0, p1);
                const bool first = !SWA && (t == cur.t0);
                if (first || __any(rm > THR)) {
                    const float dl = first ? rm : __builtin_fmaxf(rm, 0.f);
                    mhat += dl;
#pragma unroll
                    for (int r = 0; r < 16; ++r) { p0[r] -= dl; p1[r] -= dl; }
#pragma unroll
                    for (int r = 0; r < 16; ++r) negm[r] = -mhat;
                    asm volatile("" : "+v"(negm));
                    const float f = __builtin_amdgcn_exp2f(-dl); l_reg *= f;
                    if (!first) {
                        if (hi == 0) wsf[r32] = f;
#pragma unroll
                        for (int r = 0; r < 16; ++r) { const float fr_ = wsf[crow(r, hi)]; o[0][r] *= fr_; o[1][r] *= fr_; }
                    }
                }
#pragma unroll
                for (int r = 0; r < 16; ++r) { p0[r] = __builtin_amdgcn_exp2f(p0[r]); p1[r] = __builtin_amdgcn_exp2f(p1[r]); }
                float sa = fadd_s(p0[0], p0[1]), sb = fadd_s(p1[0], p1[1]);
#pragma unroll
                for (int r = 2; r < 16; ++r) { sa = fadd_s(sa, p0[r]); sb = fadd_s(sb, p1[r]); }
                l_reg += fadd_s(sa, sb);
                u32x4 pw[4];
#pragma unroll
                for (int j = 0; j < 4; ++j) { pw[0][j] = cvtpk(p0[2 * j], p0[2 * j + 1]); pw[1][j] = cvtpk(p0[8 + 2 * j], p0[9 + 2 * j]); pw[2][j] = cvtpk(p1[2 * j], p1[2 * j + 1]); pw[3][j] = cvtpk(p1[8 + 2 * j], p1[9 + 2 * j]); }
#pragma unroll
                for (int d0 = 0; d0 < 2; ++d0)
#pragma unroll
                    for (int ks = 0; ks < 4; ++ks) { const s16x4 lo = vlo[d0 * 4 + ks], hh = vhi[d0 * 4 + ks];
                        const bf16x8 vf = (bf16x8){lo[0], lo[1], lo[2], lo[3], hh[0], hh[1], hh[2], hh[3]};
                        o[d0] = __builtin_amdgcn_mfma_f32_32x32x16_bf16(__builtin_bit_cast(bf16x8, pw[ks]), vf, o[d0], 0, 0, 0); }
            }
            if (t + 1 < cur.t1) ATT_WAIT_BAR();
            slot ^= 1;
        }
        if (has_next) ATT_LOADQ(nxt);
        { auto rr = __builtin_amdgcn_permlane32_swap(__float_as_uint(l_reg), __float_as_uint(l_reg), false, false); l_reg = __uint_as_float(rr[0]) + __uint_as_float(rr[1]); }
        if (hi == 0) wsf[32 + r32] = l_reg;
        float rli[16];
#pragma unroll
        for (int r = 0; r < 16; ++r) rli[r] = __builtin_amdgcn_rcpf(wsf[32 + crow(r, hi)]);
        {
            __attribute__((address_space(3))) bf16_t* stg = (__attribute__((address_space(3))) bf16_t*)((lds_ptr)shm + LDS_OST) + wid * 2048;
#pragma unroll
            for (int r = 0; r < 16; ++r) { const int orow = crow(r, hi);
#pragma unroll
                for (int d0 = 0; d0 < 2; ++d0) { const float v = o[d0][r] * rli[r]; stg[orow * 64 + d0 * 32 + r32] = (bf16_t)(cvtpk(v, v) & 0xffffu); } }
            bf16_t* Ow = B.O + (cur.rowbase + w0) * 1024 + cur.ocol + hsub * 64;
#pragma unroll
            for (int i = 0; i < 4; ++i) { const int row = i * 8 + (lane >> 3), ch = lane & 7; const u32x4 v = *(const __attribute__((address_space(3))) u32x4*)(stg + row * 64 + ch * 8); *(u32x4*)(Ow + (long)row * 1024 + ch * 8) = v; }
        }
        cur = nxt;
    }
    ATT_WAIT_BAR();
#undef ATT_DMA
#undef ATT_WAIT_BAR
#undef ATT_LOADQ
}
}

constexpr int NWAVES = 8;
constexpr int N_LAUNCHES = MK_N_LAUNCHES;
constexpr int PER_PHASE = 9;
constexpr int BATCH = 16, SEQ = 2048, D = 1024, FF = 2816, M = BATCH * SEQ;
constexpr int NGU = 2 * FF  , NWIN = 1280, NUP = 1792, KUP = 384;

constexpr size_t MiB = 1u << 20;
constexpr size_t WS_CTL = 0, CTL_ZERO_BYTES = 1 * MiB;
constexpr size_t WS_SS1 = 256 * 1024, WS_SS2 = 384 * 1024, WS_SSQ = 512 * 1024, WS_SSKV = 640 * 1024, WS_SS0 = 768 * 1024;
constexpr size_t WS_ROPE = 1 * MiB;
constexpr size_t WS_W1GU = 2 * MiB, WS_W1D = 13 * MiB, WS_W2GU = 19 * MiB, WS_W2D = 30 * MiB, WS_WIN = 36 * MiB, WS_WUP = 39 * MiB, WS_WO = 41 * MiB;
constexpr size_t WS_XB = 48 * MiB;
constexpr size_t WS_HID = 112 * MiB;
constexpr size_t WS_HQKV = 112 * MiB, WS_KPE = 136 * MiB, WS_SQ = 138 * MiB, WS_SK = 170 * MiB, WS_SV = 178 * MiB, WS_QM = 186 * MiB, WS_KN = 234 * MiB, WS_VM = 266 * MiB;
constexpr size_t WS_Y = 298 * MiB, WS_END = 362 * MiB;
static_assert(WS_HID + (size_t)M * FF * 2 <= WS_Y && WS_VM + (size_t)M * 512 * 2 <= WS_Y && WS_Y + (size_t)M * D * 2 <= WS_END, "d_ws map");
static_assert(WS_W1GU + (size_t)NGU * D * 2 <= WS_W1D && WS_W1D + (size_t)D * FF * 2 <= WS_W2GU && WS_W2GU + (size_t)NGU * D * 2 <= WS_W2D && WS_W2D + (size_t)D * FF * 2 <= WS_WIN &&
              WS_WIN + (size_t)NWIN * D * 2 <= WS_WUP && WS_WUP + (size_t)NUP * KUP * 2 <= WS_WO && WS_WO + (size_t)D * D * 2 <= WS_XB, "weight map");
constexpr int CW_BAR = 4096;

constexpr int RING_OFF = 0, RING_BYTES = 131072;
constexpr int LDSCTL_OFF = RING_BYTES, MISC_OFF = LDSCTL_OFF + 320;
constexpr int LDS_BYTES = 147456;
static_assert(MISC_OFF + 128 <= LDS_BYTES && att::LDS_BYTES <= RING_BYTES, "LDS map");

#define GAS __attribute__((address_space(1)))
#define LAS __attribute__((address_space(3)))
typedef unsigned short bf16;
typedef unsigned v4u __attribute__((ext_vector_type(4)));
typedef float f32x4 __attribute__((ext_vector_type(4)));
typedef GAS unsigned gu32;
#define RLX_AGENT __ATOMIC_RELAXED, __HIP_MEMORY_SCOPE_AGENT
#define LDS_WAIT() asm volatile("s_waitcnt lgkmcnt(0)" ::: "memory")
#define VM_WAIT() asm volatile("s_waitcnt vmcnt(0)" ::: "memory")
__device__ __forceinline__ unsigned f2bf(float f) { unsigned u = __builtin_bit_cast(unsigned, f); return (u + 0x7fffu + ((u >> 16) & 1u)) >> 16; }
__device__ __forceinline__ unsigned pk2(float lo, float hi) { return f2bf(lo) | (f2bf(hi) << 16); }

#define XB_TMO      128
#define XB_XCNT(j)  (256  + 64 * (j))
#define XB_XSUB(j)  (1280 + 64 * (j))
#define XB_XGEN(j)  (2304 + 64 * (j))
#define XB_TOP      3328
#define XB_TOPGEN   3392
#define XCD_BAR_WORDS 3456
#define XB_SPIN_CAP (1u << 18)
__device__ __forceinline__ unsigned xb_ld(unsigned* p)              { return __hip_atomic_load(p, __ATOMIC_RELAXED, __HIP_MEMORY_SCOPE_AGENT); }
__device__ __forceinline__ unsigned xb_add(unsigned* p, unsigned v) { return __hip_atomic_fetch_add(p, v, __ATOMIC_RELAXED, __HIP_MEMORY_SCOPE_AGENT); }
__device__ __forceinline__ unsigned xb_xcc_id() { return (unsigned)__builtin_amdgcn_s_getreg((3 << 11) | 20) & 0xFu; }
#define XB_SPIN(cond, bar) do { unsigned _sp = 0; while (cond) { __builtin_amdgcn_s_sleep(1); \
    if ((++_sp & 255u) == 0u) { if (xb_ld(&(bar)[XB_TMO])) break; if (_sp > XB_SPIN_CAP) { atomicAdd(&(bar)[XB_TMO], 1u); break; } } } } while (0)
struct XcdBarrier { unsigned* bar; unsigned x; volatile LAS unsigned* st; };
__device__ __forceinline__ XcdBarrier xcd_barrier_post(unsigned* bar, volatile LAS unsigned* st) {
    XcdBarrier b; b.bar = bar; b.x = xb_xcc_id(); b.st = st;
    if (threadIdx.x == 0) (void)xb_add(&bar[XB_XCNT(b.x)], 1u);
    return b;
}
__device__ __forceinline__ void xcd_barrier_complete(unsigned* bar, unsigned x, unsigned& nloc, unsigned& nx) {
    const unsigned G = gridDim.x * gridDim.y * gridDim.z;
    unsigned sum, cnt, mine, sp = 0u;
    for (;;) {
        sum = 0u; cnt = 0u; mine = 0u;
#pragma unroll
        for (unsigned j = 0; j < 16; ++j) { const unsigned c = xb_ld(&bar[XB_XCNT(j)]); sum += c; cnt += (c > 0u) ? 1u : 0u; mine = (j == x) ? c : mine; }
        if (sum == G) break;
        __builtin_amdgcn_s_sleep(1);
        if ((++sp & 255u) == 0u) { if (xb_ld(&bar[XB_TMO])) break; if (sp > XB_SPIN_CAP) { atomicAdd(&bar[XB_TMO], 1u); break; } }
    }
    nloc = mine > 0u ? mine : 1u; nx = cnt > 0u ? cnt : 1u;
}
__device__ __forceinline__ void xcd_barrier(const XcdBarrier& b) {
    asm volatile("s_waitcnt vmcnt(0)" ::: "memory");
    __syncthreads();
    if (threadIdx.x == 0) {
        unsigned* bar = b.bar;
        __builtin_amdgcn_s_waitcnt(0);
        unsigned nloc = b.st[0], nx = b.st[1];
        if (nloc == 0u) { xcd_barrier_complete(bar, b.x, nloc, nx); b.st[0] = nloc; b.st[1] = nx; }
        const unsigned old = xb_add(&bar[XB_XSUB(b.x)], 1u);
        const unsigned gen = old / nloc;
        if (old + 1u == (gen + 1u) * nloc) {
            __builtin_amdgcn_fence(__ATOMIC_RELEASE, "agent");
            asm volatile("s_waitcnt vmcnt(0)" ::: "memory");
            const unsigned og = xb_add(&bar[XB_TOP], 1u);
            const unsigned tg = og / nx;
            if (og + 1u == (tg + 1u) * nx) xb_add(&bar[XB_TOPGEN], 1u);
            else XB_SPIN(xb_ld(&bar[XB_TOPGEN]) == tg, bar);
            __builtin_amdgcn_fence(__ATOMIC_ACQUIRE, "agent");
            xb_add(&bar[XB_XGEN(b.x)], 1u);
            asm volatile("s_waitcnt vmcnt(0)" ::: "memory");
        } else {
            XB_SPIN(xb_ld(&bar[XB_XGEN(b.x)]) == gen, bar);
            __builtin_amdgcn_fence(__ATOMIC_ACQUIRE, "agent");
            asm volatile("s_waitcnt vmcnt(0)" ::: "memory");
        }
    }
    __syncthreads();
}

__host__ __device__ __forceinline__ int rope_logical(int jj) { return 16 * ((jj >> 2) & 1) + 4 * (jj >> 3) + (jj & 3); }
__host__ __device__ __forceinline__ int win_src(int p) {
    const int pn = p >> 8, j = p & 255, bj = j >> 7, wc = (j >> 5) & 3, jj = j & 31;
    if (pn == 0) return j;
    if (pn == 1) { if (j < 128) return 256 + j; if (j < 160) return 384 + rope_logical(jj); return -1; }
    if (pn < 4) return 416 + (4 * (pn - 2) + wc) * 64 + 32 * bj + jj;
    return (wc < 2 ? 928 + wc * 64 : 1056 + (wc - 2) * 64) + 32 * bj + jj;
}
__host__ __device__ __forceinline__ int up_src(int p, bool& is_kv) {
    const int pn = p >> 8, j = p & 255, bj = j >> 7, wc = (j >> 5) & 3, jj = j & 31;
    if (pn < 2) { is_kv = false; return (4 * pn + wc) * 96 + 32 * bj + jj; }
    if (pn == 2) { is_kv = false; return (4 * bj + wc) * 96 + 64 + rope_logical(jj); }
    is_kv = true;
    if (pn < 5) return (4 * (pn - 3) + wc) * 128 + 32 * bj + jj;
    return (4 * (pn - 5) + wc) * 128 + 64 + 32 * bj + jj;
}

struct Frame {
    LAS unsigned char* lds;
    volatile LAS unsigned* MISC;
    gu32* ctl;
    int tid, lane, wave;
    int vcu, G;
};
struct Args { const float* in[23]; float* out; unsigned char* ws; int ph_lo, ph_hi, li, pad; };

__device__ __forceinline__ float wave_sum(float v) {
#pragma unroll
    for (int o = 1; o < 64; o <<= 1) v += __shfl_xor(v, o);
    return v;
}
__device__ __forceinline__ void p0_item(const float* W, int ldw, int ks0, const float* g, int col, bf16* dst, int Kp, LAS float* scr, int lane) {
    const bool z = (W == nullptr) || (col < 0);
    float wv[32];
#pragma unroll
    for (int i = 0; i < 32; ++i) { const int kk = 2 * i + (lane >> 5); wv[i] = z ? 0.f : W[(size_t)(ks0 + kk) * ldw + col]; }
#pragma unroll
    for (int i = 0; i < 32; ++i) { const int kk = 2 * i + (lane >> 5); float v = wv[i]; if (!z && g) v *= g[ks0 + kk]; scr[kk * 33 + (lane & 31)] = v; }
    LDS_WAIT(); asm volatile("" ::: "memory");
    const int c = lane & 7;
#pragma unroll
    for (int j = 0; j < 4; ++j) { const int n = (lane >> 3) + 8 * j; const LAS float* s = scr + (8 * c) * 33 + n;
        v4u o; o.x = pk2(s[0 * 33], s[1 * 33]); o.y = pk2(s[2 * 33], s[3 * 33]); o.z = pk2(s[4 * 33], s[5 * 33]); o.w = pk2(s[6 * 33], s[7 * 33]);
        *(GAS v4u*)(dst + (size_t)n * Kp + 8 * c) = o; }
    LDS_WAIT(); asm volatile("" ::: "memory");
}

__device__ __forceinline__ void convert_weights(Frame& F, const Args& a, int set, int worker, int nworkers) {
    LAS float* scr = (LAS float*)(F.lds + RING_OFF + F.wave * 16384);
    const int lane = F.lane; unsigned char* ws = a.ws;
    constexpr int I_GU = 16 * 176, I_D = 44 * 32, I_WIN = 16 * 40, I_UP = 6 * 56, I_WO = 16 * 32;
    const int nitems = set == 0 ? I_GU + I_D + I_WIN + I_UP : I_GU + I_D + I_WO;
    for (int it = worker; it < nitems; it += nworkers) {
        int r = it; const int f = set;
        if (r < I_GU) { const int kb = r / 176, nb = r % 176, p = nb * 32 + (lane & 31);
            const float* W = ((p >> 7) & 1) ? a.in[f ? 21 : 3] : a.in[f ? 20 : 2]; const int col = 128 * (p >> 8) + (p & 127);
            p0_item(W, FF, kb * 64, a.in[f ? 19 : 1], col, (bf16*)(ws + (f ? WS_W2GU : WS_W1GU)) + (size_t)(nb * 32) * D + kb * 64, D, scr, lane); continue; }
        r -= I_GU;
        if (r < I_D) { const int kb = r / 32, nb = r % 32;
            p0_item(a.in[f ? 22 : 4], D, kb * 64, nullptr, nb * 32 + (lane & 31), (bf16*)(ws + (f ? WS_W2D : WS_W1D)) + (size_t)(nb * 32) * FF + kb * 64, FF, scr, lane); continue; }
        r -= I_D;
        if (set == 1) { const int kb = r / 32, nb = r % 32;
            p0_item(a.in[18], D, kb * 64, nullptr, nb * 32 + (lane & 31), (bf16*)(ws + WS_WO) + (size_t)(nb * 32) * D + kb * 64, D, scr, lane); continue; }
        if (r < I_WIN) { const int kb = r / 40, nb = r % 40;
            p0_item(a.in[6], 1184, kb * 64, a.in[5], win_src(nb * 32 + (lane & 31)), (bf16*)(ws + WS_WIN) + (size_t)(nb * 32) * D + kb * 64, D, scr, lane); continue; }
        r -= I_WIN;
        { const int kb = r / 56, nb = r % 56; bool kv; const int col = up_src(nb * 32 + (lane & 31), kv);
            const bool live = kv ? (kb >= 4) : (kb < 4);
            p0_item(live ? (kv ? a.in[10] : a.in[8]) : nullptr, kv ? 1024 : 768, kv ? (kb - 4) * 64 : kb * 64, kv ? a.in[9] : a.in[7], col, (bf16*)(ws + WS_WUP) + (size_t)(nb * 32) * KUP + kb * 64, KUP, scr, lane); }
    }
}

__device__ __forceinline__ void p0_prologue(Frame& F, const Args& a) {
    const int gw = F.vcu * NWAVES + F.wave, NGW = F.G * NWAVES, lane = F.lane;
    unsigned char* ws = a.ws;
    convert_weights(F, a, 0, gw, NGW);
    const float* x = a.in[0]; bf16* XB = (bf16*)(ws + WS_XB); float* ss0 = (float*)(ws + WS_SS0);
    for (int m0 = gw * 4; m0 < M; m0 += NGW * 4) {
        f32x4 v[4][4];
#pragma unroll
        for (int q = 0; q < 4; ++q) { const GAS f32x4* xr = (const GAS f32x4*)(x + (size_t)(m0 + q) * D) + 2 * lane;
#pragma unroll
            for (int j = 0; j < 2; ++j) { v[q][2 * j] = __builtin_nontemporal_load(xr + 128 * j); v[q][2 * j + 1] = __builtin_nontemporal_load(xr + 128 * j + 1); } }
#pragma unroll
        for (int q = 0; q < 4; ++q) { float s = 0.f;
#pragma unroll
            for (int j = 0; j < 4; ++j) s += (v[q][j].x * v[q][j].x + v[q][j].y * v[q][j].y) + (v[q][j].z * v[q][j].z + v[q][j].w * v[q][j].w);
            s = wave_sum(s); if (lane == 0) ss0[m0 + q] = s;
            GAS v4u* o16 = (GAS v4u*)(XB + (size_t)(m0 + q) * D) + lane;
#pragma unroll
            for (int j = 0; j < 2; ++j) { v4u o; o.x = pk2(v[q][2 * j].x, v[q][2 * j].y); o.y = pk2(v[q][2 * j].z, v[q][2 * j].w); o.z = pk2(v[q][2 * j + 1].x, v[q][2 * j + 1].y); o.w = pk2(v[q][2 * j + 1].z, v[q][2 * j + 1].w); o16[64 * j] = o; } }
    }
    float* rc = (float*)(ws + WS_ROPE); float* rsn = rc + 2048 * 16;
    for (int e = gw * 64 + lane; e < 2048 * 16; e += NGW * 64) { const int pos = e >> 4, i = e & 15;
        const float inv = 1.0f / powf(10000.0f, (float)(2 * i) / 32.0f); const float ang = (float)pos * inv; rc[e] = cosf(ang); rsn[e] = sinf(ang); }
}

__global__ void __launch_bounds__(NWAVES * 64, 2) mk_fwd(Args args) {
    extern __shared__ __attribute__((aligned(16))) unsigned char lds[];
    Frame F;
    F.lds = (LAS unsigned char*)lds;
    F.MISC = (volatile LAS unsigned*)(F.lds + MISC_OFF);
    F.tid = threadIdx.x; F.lane = F.tid & 63; F.wave = __builtin_amdgcn_readfirstlane(F.tid >> 6);
    F.G = gridDim.x; { const int bx = blockIdx.x; F.vcu = (F.G % 8 == 0) ? (bx % 8) * (F.G / 8) + bx / 8 : bx; }
    unsigned char* ws = args.ws;
    F.ctl = (gu32*)(ws + WS_CTL);
    for (int u = F.tid; u < (LDS_BYTES - LDSCTL_OFF) / 4; u += NWAVES * 64) ((LAS unsigned*)(F.lds + LDSCTL_OFF))[u] = 0u;
    __syncthreads();
    XcdBarrier bar; bar.bar = (unsigned*)(F.ctl + CW_BAR); bar.x = 0; bar.st = nullptr;
    if (N_LAUNCHES != PER_PHASE) bar = xcd_barrier_post((unsigned*)(F.ctl + CW_BAR), F.MISC + 8);
#define GRID_BAR() do { if (N_LAUNCHES != PER_PHASE) xcd_barrier(bar); } while (0)
    const int lo = args.ph_lo, hi = args.ph_hi;
#define IN(k) (lo <= (k) && (k) < hi)
#define BOTH(k) (IN(k) && IN((k) + 1))

    bf16* XB = (bf16*)(ws + WS_XB); bf16* HID = (bf16*)(ws + WS_HID); bf16* Y = (bf16*)(ws + WS_Y);
    float* ss0 = (float*)(ws + WS_SS0); float* ss1 = (float*)(ws + WS_SS1); float* ss2 = (float*)(ws + WS_SS2);
    pg8::MixBufs MB;
    MB.HQKV = (bf16*)(ws + WS_HQKV); MB.KPE = (bf16*)(ws + WS_KPE); MB.SQ = (bf16*)(ws + WS_SQ); MB.SK = (bf16*)(ws + WS_SK); MB.SV = (bf16*)(ws + WS_SV);
    MB.QM = (bf16*)(ws + WS_QM); MB.KN = (bf16*)(ws + WS_KN); MB.VM = (bf16*)(ws + WS_VM);
    MB.ssq = (float*)(ws + WS_SSQ); MB.sskv = (float*)(ws + WS_SSKV); MB.ss1 = ss1;
    MB.g_kr = args.in[14]; MB.g_sq = args.in[15]; MB.g_sk = args.in[16]; MB.g_qn = args.in[11]; MB.g_qr = args.in[12]; MB.g_kn = args.in[13];
    MB.rcos = (const float*)(ws + WS_ROPE); MB.rsin = MB.rcos + 2048 * 16; MB.noatom = 0;

    if (IN(0)) { REPS(0) p0_prologue(F, args); if (BOTH(0)) GRID_BAR(); }
    if (IN(1)) { pg8::Gemm g{XB, (const bf16*)(ws + WS_W1GU), M, NGU, D}; pg8::StatOrder<pg8::StaticOrder> S; S.S.init(M, NGU, D, F.G, (int)blockIdx.x); S.ssA = ss0; S.ssB = ss0; S.pnB = 1 << 30; S.lds = F.lds;
        pg8::EpiSwiGLU E{HID, F.lds, FF};
        REPS(1) pg8::gemm_phase<pg8::EpiSwiGLU, pg8::StatOrder<pg8::StaticOrder>, MK_ALIGN_GU, true>(F.lds + RING_OFF, g, S, E);
        if (MK_DUP == 101) { pg8::EpiNull EN; pg8::gemm_phase<pg8::EpiNull, pg8::StaticOrder, true, true>(F.lds + RING_OFF, g, S.S, EN); }
        if (BOTH(1)) GRID_BAR(); }
    if (IN(2)) { pg8::Gemm g{HID, (const bf16*)(ws + WS_W1D), M, D, FF}; pg8::StaticOrder S; S.init(M, D, FF, F.G, (int)blockIdx.x);
        { pg8::EpiRes E{XB, XB, nullptr, ss1, 0.5f, F.lds + RING_OFF};
        pg8::gemm_phase<pg8::EpiRes, pg8::StaticOrder, true, true>(F.lds + RING_OFF, g, S, E); }
        if (MK_DUP == 2) { pg8::EpiRes E{XB, (bf16*)(ws + WS_Y), nullptr, nullptr, 0.f, F.lds + RING_OFF};
        pg8::gemm_phase<pg8::EpiRes, pg8::StaticOrder, true, true>(F.lds + RING_OFF, g, S, E); }
        if (BOTH(2)) GRID_BAR(); }
    if (IN(3)) { pg8::Gemm g{XB, (const bf16*)(ws + WS_WIN), M, NWIN, D}; pg8::StatOrder<pg8::StaticOrder> S; S.S.init(M, NWIN, D, F.G, (int)blockIdx.x); S.ssA = ss1; S.ssB = ss1; S.pnB = 1 << 30; S.lds = F.lds;
        REPS(3) { pg8::EpiWin E{MB, F.lds}; E.B.noatom = rep;
        pg8::gemm_phase<pg8::EpiWin, pg8::StatOrder<pg8::StaticOrder>, true, true>(F.lds + RING_OFF, g, S, E); }
        { const int nu3 = (M / 256) * (NWIN / 256), maxu = (nu3 + F.G - 1) / F.G, rem = nu3 - (maxu - 1) * F.G, nidle = F.G - rem;
          if (nidle == 0) convert_weights(F, args, 1, (int)blockIdx.x * NWAVES + F.wave, F.G * NWAVES);
          else if ((int)blockIdx.x >= rem) convert_weights(F, args, 1, ((int)blockIdx.x - rem) * NWAVES + F.wave, nidle * NWAVES); }
        if (BOTH(3)) GRID_BAR(); }
    if (IN(4)) { pg8::Gemm g{MB.HQKV, (const bf16*)(ws + WS_WUP), M, NUP, KUP}; pg8::StatOrder<pg8::UpOrder> S; S.S.S.init(M, NUP, KUP, F.G, (int)blockIdx.x); S.ssA = MB.ssq; S.ssB = MB.sskv; S.pnB = 3; S.lds = F.lds;
        pg8::EpiUp E{MB, F.lds};
        REPS(4) pg8::gemm_phase<pg8::EpiUp, pg8::StatOrder<pg8::UpOrder>, true, true>(F.lds + RING_OFF, g, S, E);
        const float* sink = args.in[17];
        const int upc = (1024 + F.G - 1) / F.G, au0 = F.vcu * upc, anu = au0 >= 1024 ? 0 : (1024 - au0 < upc ? 1024 - au0 : upc);
        REPS(40) { att::Bufs AB{MB.SQ, MB.SK, nullptr, MB.SV, Y}; if (anu > 0) att::att_phase<true>(au0, anu, AB, (char*)lds + RING_OFF, sink); }
        if (BOTH(4)) GRID_BAR(); }
    if (IN(5)) {
        const int upc = (1024 + F.G - 1) / F.G, au0 = F.vcu * upc, anu = au0 >= 1024 ? 0 : (1024 - au0 < upc ? 1024 - au0 : upc);
        REPS(5) { att::Bufs AB{MB.QM, MB.KN, MB.KPE, MB.VM, Y}; if (anu > 0) att::att_phase<false>(au0, anu, AB, (char*)lds + RING_OFF, nullptr); }
        if (BOTH(5)) GRID_BAR(); }
    if (IN(6)) { pg8::Gemm g{Y, (const bf16*)(ws + WS_WO), M, D, D}; pg8::StaticOrder S; S.init(M, D, D, F.G, (int)blockIdx.x);
        { pg8::EpiRes E{XB, XB, nullptr, ss2, 1.0f, F.lds + RING_OFF};
        pg8::gemm_phase<pg8::EpiRes, pg8::StaticOrder, true, true>(F.lds + RING_OFF, g, S, E); }
        if (MK_DUP == 6) { pg8::EpiRes E{XB, (bf16*)(ws + WS_HID), nullptr, nullptr, 0.f, F.lds + RING_OFF};
        pg8::gemm_phase<pg8::EpiRes, pg8::StaticOrder, true, true>(F.lds + RING_OFF, g, S, E); }
        if (BOTH(6)) GRID_BAR(); }
    if (IN(7)) { pg8::Gemm g{XB, (const bf16*)(ws + WS_W2GU), M, NGU, D}; pg8::StatOrder<pg8::StaticOrder> S; S.S.init(M, NGU, D, F.G, (int)blockIdx.x); S.ssA = ss2; S.ssB = ss2; S.pnB = 1 << 30; S.lds = F.lds;
        pg8::EpiSwiGLU E{HID, F.lds, FF};
        pg8::gemm_phase<pg8::EpiSwiGLU, pg8::StatOrder<pg8::StaticOrder>, MK_ALIGN_GU, true>(F.lds + RING_OFF, g, S, E);
        if (BOTH(7)) GRID_BAR(); }
    if (IN(8)) { pg8::Gemm g{HID, (const bf16*)(ws + WS_W2D), M, D, FF}; pg8::StaticOrder S; S.init(M, D, FF, F.G, (int)blockIdx.x);
        pg8::EpiRes E{XB, nullptr, args.out, nullptr, 0.5f, F.lds + RING_OFF};
        pg8::gemm_phase<pg8::EpiRes, pg8::StaticOrder, true, true>(F.lds + RING_OFF, g, S, E); }
#undef IN
#undef BOTH
#undef GRID_BAR
}

extern "C" void kernel_launch(void* const* d_in, const int* in_sizes, int n_in, void* d_out, int out_size, void* d_ws, size_t ws_size, hipStream_t stream) {
    static int grid = 0;
    if (grid == 0) {
        if (n_in != 23 || in_sizes[0] != M * D || out_size != M * D || ws_size < WS_END) { fprintf(stderr, "kernel_launch: unexpected shapes (n_in %d, in0 %d, out %d, ws %zu); nothing launched\n", n_in, n_in > 0 ? in_sizes[0] : -1, out_size, ws_size); grid = -1; return; }
        int dev = 0, cus = 0, per_cu = 0;
        if (hipGetDevice(&dev) != hipSuccess || hipDeviceGetAttribute(&cus, hipDeviceAttributeMultiprocessorCount, dev) != hipSuccess) { grid = -1; return; }
        if (hipFuncSetAttribute((const void*)mk_fwd, hipFuncAttributeMaxDynamicSharedMemorySize, LDS_BYTES) != hipSuccess) { fprintf(stderr, "kernel_launch: hipFuncSetAttribute failed\n"); grid = -1; return; }
        if (hipOccupancyMaxActiveBlocksPerMultiprocessor(&per_cu, (const void*)mk_fwd, NWAVES * 64, LDS_BYTES) != hipSuccess || per_cu < 1) { fprintf(stderr, "kernel_launch: occupancy query reports %d workgroups per CU\n", per_cu); }
        (void)hipGetLastError();
        grid = cus;
    }
    if (grid < 0) return;
    if (hipMemsetAsync((char*)d_ws + WS_CTL, 0, CTL_ZERO_BYTES, stream) != hipSuccess) return;
    Args a{};
    for (int i = 0; i < 23; ++i) a.in[i] = (const float*)d_in[i];
    a.out = (float*)d_out; a.ws = (unsigned char*)d_ws;
    if (N_LAUNCHES == PER_PHASE) {
        for (int li = 0; li < PER_PHASE; ++li) { a.ph_lo = li; a.ph_hi = li + 1; a.li = li; hipLaunchKernelGGL(mk_fwd, dim3(grid), dim3(NWAVES * 64), LDS_BYTES, stream, a); }
    } else {
        a.ph_lo = 0; a.ph_hi = PER_PHASE; a.li = 0;
        hipLaunchKernelGGL(mk_fwd, dim3(grid), dim3(NWAVES * 64), LDS_BYTES, stream, a);
    }
}
```
